# Optimizing an MI355X kernel written in HIP

```python
import jax, jax.numpy as jnp
from jax import lax
import numpy as np

D_MODEL = 2048
BATCH = 2
SEQ = 4096
DEPTH = 4

MLA_HEADS = 8
QK_NOPE_DIM = 128
QK_ROPE_DIM = 64
V_HEAD_DIM = 128
Q_LORA_RANK = 768
KV_LORA_RANK = 512
ROPE_THETA = 10000.0
Q_BLOCK = 128
ATTN_WIDTH = MLA_HEADS * V_HEAD_DIM
SGU_GROUPS = 8
SGU_GROUP_DIM = 128
SGU_WIDTH = SGU_GROUPS * SGU_GROUP_DIM
CHUNK = 128
MIX_WIDTH = ATTN_WIDTH + SGU_WIDTH
SPLIT_AB = (Q_LORA_RANK,
            Q_LORA_RANK + KV_LORA_RANK,
            Q_LORA_RANK + KV_LORA_RANK + QK_ROPE_DIM,
            Q_LORA_RANK + KV_LORA_RANK + QK_ROPE_DIM + SGU_WIDTH)
IN_AB_WIDTH = Q_LORA_RANK + KV_LORA_RANK + QK_ROPE_DIM + 2 * SGU_WIDTH
POOL_WINDOWS = (2, 4, 8, 16)
POOL_GROUP_DIM = D_MODEL // 4
D_FF = 5632
N_EXPERTS = 8
TOP_K = 2
D_FF_EXPERT = 2816
N_EVEN = (DEPTH + 1) // 2
N_ODD = DEPTH // 2
DEEPNORM_ALPHA = (2 * DEPTH) ** 0.25
DEEPNORM_BETA = (8 * DEPTH) ** -0.25
LN_EPS = 1e-5
RMS_EPS = 1e-6

kernel_name = "hybrid_mla_sgu_pool_moe_deepnorm_adaln"


def layer_norm(x, g, b):
    xf = x.astype(jnp.float32)
    mu = jnp.mean(xf, axis=-1, keepdims=True)
    var = jnp.mean(jnp.square(xf - mu), axis=-1, keepdims=True)
    return ((xf - mu) * lax.rsqrt(var + LN_EPS) * g + b).astype(x.dtype)


def rms_norm(x, g):
    xf = x.astype(jnp.float32)
    return (xf * lax.rsqrt(jnp.mean(xf * xf, axis=-1, keepdims=True) + RMS_EPS) * g).astype(x.dtype)


def rope_tables(positions):
    inv = ROPE_THETA ** (-jnp.arange(0, QK_ROPE_DIM, 2, dtype=jnp.float32) / QK_ROPE_DIM)
    ang = positions.astype(jnp.float32)[..., None] * inv
    return jnp.cos(ang), jnp.sin(ang)


def apply_rope(x, cos, sin):
    half = QK_ROPE_DIM // 2
    xf = x.astype(jnp.float32)
    x1, x2 = xf[..., :half], xf[..., half:]
    return jnp.concatenate([x1 * cos - x2 * sin, x1 * sin + x2 * cos], axis=-1).astype(x.dtype)


def ada_modulation(c, w, b):
    mod = jax.nn.silu(c) @ w + b
    shift, scale, gate = jnp.split(mod[:, None, :], 3, axis=-1)
    return shift, scale, gate


def mla_attention(q_nope, q_rope, k_nope, k_rope, v):
    b_, s_, h_, dv = v.shape
    n_blocks = s_ // Q_BLOCK
    sm_scale = (QK_NOPE_DIM + QK_ROPE_DIM) ** -0.5
    k_pos = jnp.arange(s_)

    def block(i):
        start = i * Q_BLOCK
        qn = lax.dynamic_slice_in_dim(q_nope, start, Q_BLOCK, axis=1)
        qr = lax.dynamic_slice_in_dim(q_rope, start, Q_BLOCK, axis=1)
        s = (jnp.einsum('bqhd,bkhd->bhqk', qn, k_nope, preferred_element_type=jnp.float32)
             + jnp.einsum('bqhr,bkr->bhqk', qr, k_rope, preferred_element_type=jnp.float32)) * sm_scale
        causal = (start + jnp.arange(Q_BLOCK))[:, None] >= k_pos[None, :]
        s = jnp.where(causal, s, -jnp.inf)
        p = jax.nn.softmax(s, axis=-1).astype(v.dtype)
        return jnp.einsum('bhqk,bkhd->bqhd', p, v)

    out = lax.map(block, jnp.arange(n_blocks))
    return jnp.moveaxis(out, 0, 1).reshape(b_, s_, h_ * dv)


def spatial_gating(u, v, norm_g, norm_b, w_s, b_s):
    b_, s_, _ = v.shape
    n_chunks = s_ // CHUNK
    vg = v.reshape(b_, s_, SGU_GROUPS, SGU_GROUP_DIM)
    vg = layer_norm(vg, norm_g.reshape(SGU_GROUPS, SGU_GROUP_DIM), norm_b.reshape(SGU_GROUPS, SGU_GROUP_DIM))
    vg = vg.reshape(b_, n_chunks, CHUNK, SGU_GROUPS, SGU_GROUP_DIM)
    w_causal = w_s * jnp.tril(jnp.ones((CHUNK, CHUNK), dtype=w_s.dtype))
    s = jnp.einsum('gts,bnsgc->bntgc', w_causal, vg) + b_s.T[None, None, :, :, None]
    return u * s.reshape(b_, s_, SGU_WIDTH)


def mixer_ab(h, cos, sin, w_in, q_norm_g, w_q_up, kv_norm_g, w_kv_up,
             sgu_norm_g, sgu_norm_b, sgu_w, sgu_b, w_out):
    b_, s_, _ = h.shape
    z = h @ w_in
    cq, ckv, kr, zu, zv = jnp.split(z, SPLIT_AB, axis=-1)
    q = (rms_norm(cq, q_norm_g) @ w_q_up).reshape(b_, s_, MLA_HEADS, QK_NOPE_DIM + QK_ROPE_DIM)
    q_nope = q[..., :QK_NOPE_DIM]
    q_rope = apply_rope(q[..., QK_NOPE_DIM:], cos[:, :, None, :], sin[:, :, None, :])
    kv = (rms_norm(ckv, kv_norm_g) @ w_kv_up).reshape(b_, s_, MLA_HEADS, QK_NOPE_DIM + V_HEAD_DIM)
    k_nope, v = kv[..., :QK_NOPE_DIM], kv[..., QK_NOPE_DIM:]
    k_rope = apply_rope(kr, cos, sin)
    attn = mla_attention(q_nope, q_rope, k_nope, k_rope, v)
    sgu = spatial_gating(jax.nn.gelu(zu), jax.nn.gelu(zv), sgu_norm_g, sgu_norm_b, sgu_w, sgu_b)
    return jnp.concatenate([attn, sgu], axis=-1) @ w_out


def multiscale_pool(h, w_pool, pool_scale):
    s_ = h.shape[1]
    hf = h.astype(jnp.float32)
    cs0 = jnp.pad(jnp.cumsum(hf, axis=1), ((0, 0), (1, 0), (0, 0)))
    count_base = jnp.arange(1, s_ + 1, dtype=jnp.float32)[None, :, None]
    outs = []
    for gi, w in enumerate(POOL_WINDOWS):
        sl = slice(gi * POOL_GROUP_DIM, (gi + 1) * POOL_GROUP_DIM)
        cg = cs0[:, :, sl]
        lag = jnp.pad(cg, ((0, 0), (w, 0), (0, 0)))[:, 1:s_ + 1]
        mean = (cg[:, 1:] - lag) / jnp.minimum(count_base, float(w))
        d = (mean - hf[:, :, sl]).astype(h.dtype)
        outs.append(d @ w_pool[gi])
    return jnp.concatenate(outs, axis=-1) * pool_scale


def swiglu(h, w_gate, w_up, w_down):
    return (jax.nn.silu(h @ w_gate) * (h @ w_up)) @ w_down


def moe_swiglu(h, w_router, w_gate, w_up, w_down):
    b_, s_, d_ = h.shape
    t = h.reshape(-1, d_)
    logits = jnp.dot(t, w_router, preferred_element_type=jnp.float32)
    top_v, top_i = lax.top_k(logits, TOP_K)
    top_w = jax.nn.softmax(top_v, axis=-1)
    gates = jnp.sum(jax.nn.one_hot(top_i, N_EXPERTS, dtype=jnp.float32) * top_w[..., None], axis=1)
    gates = gates.astype(t.dtype)
    y = jnp.zeros_like(t)
    for e in range(N_EXPERTS):
        y = y + gates[:, e:e + 1] * swiglu(t, w_gate[e], w_up[e], w_down[e])
    return y.reshape(b_, s_, d_)


def setup_inputs(seed: int = 0) -> dict:
    key = jax.random.key(seed)
    ks = jax.random.split(key, 32)
    f32 = jnp.float32

    def nrm(k, shape, scale):
        return jax.random.normal(k, shape, f32) * scale

    D = D_MODEL
    offset = jax.random.randint(ks[2], (BATCH, 1), 0, 1024, dtype=jnp.int32)
    positions = (offset + jnp.arange(SEQ, dtype=jnp.int32)[None, :]).astype(jnp.int32)
    return {
        "x": nrm(ks[0], (BATCH, SEQ, D), 1.0),
        "c": nrm(ks[1], (BATCH, D), 1.0),
        "positions": positions,
        "ada_w": nrm(ks[3], (DEPTH, 2, D, 3 * D), 0.1 * D ** -0.5),
        "ada_b": nrm(ks[4], (DEPTH, 2, 3 * D), 0.02),
        "ln_g": 1.0 + nrm(ks[5], (DEPTH, 2, D), 0.02),
        "ln_b": nrm(ks[6], (DEPTH, 2, D), 0.02),
        "w_in_ab": nrm(ks[7], (N_EVEN, D, IN_AB_WIDTH), D ** -0.5),
        "q_norm_g": 1.0 + nrm(ks[8], (N_EVEN, Q_LORA_RANK), 0.02),
        "w_q_up": nrm(ks[9], (N_EVEN, Q_LORA_RANK, MLA_HEADS * (QK_NOPE_DIM + QK_ROPE_DIM)), Q_LORA_RANK ** -0.5),
        "kv_norm_g": 1.0 + nrm(ks[10], (N_EVEN, KV_LORA_RANK), 0.02),
        "w_kv_up": nrm(ks[11], (N_EVEN, KV_LORA_RANK, MLA_HEADS * (QK_NOPE_DIM + V_HEAD_DIM)), KV_LORA_RANK ** -0.5),
        "sgu_norm_g": 1.0 + nrm(ks[12], (N_EVEN, SGU_WIDTH), 0.02),
        "sgu_norm_b": nrm(ks[13], (N_EVEN, SGU_WIDTH), 0.02),
        "sgu_w": nrm(ks[14], (N_EVEN, SGU_GROUPS, CHUNK, CHUNK), CHUNK ** -0.5),
        "sgu_b": 1.0 + nrm(ks[15], (N_EVEN, SGU_GROUPS, CHUNK), 0.02),
        "w_out_ab": nrm(ks[16], (N_EVEN, MIX_WIDTH, D), DEEPNORM_BETA * MIX_WIDTH ** -0.5),
        "ffn_w_gate": nrm(ks[17], (N_EVEN, D, D_FF), D ** -0.5),
        "ffn_w_up": nrm(ks[18], (N_EVEN, D, D_FF), D ** -0.5),
        "ffn_w_down": nrm(ks[19], (N_EVEN, D_FF, D), DEEPNORM_BETA * D_FF ** -0.5),
        "pool_w": nrm(ks[20], (N_ODD, len(POOL_WINDOWS), POOL_GROUP_DIM, POOL_GROUP_DIM), POOL_GROUP_DIM ** -0.5),
        "pool_scale": 1.0 + nrm(ks[21], (N_ODD, D), 0.02),
        "w_out_c": nrm(ks[22], (N_ODD, D, D), DEEPNORM_BETA * D ** -0.5),
        "router_w": nrm(ks[23], (N_ODD, D, N_EXPERTS), D ** -0.5),
        "moe_w_gate": nrm(ks[24], (N_ODD, N_EXPERTS, D, D_FF_EXPERT), D ** -0.5),
        "moe_w_up": nrm(ks[25], (N_ODD, N_EXPERTS, D, D_FF_EXPERT), D ** -0.5),
        "moe_w_down": nrm(ks[26], (N_ODD, N_EXPERTS, D_FF_EXPERT, D), DEEPNORM_BETA * D_FF_EXPERT ** -0.5),
    }


def reference(x, c, positions, ada_w, ada_b, ln_g, ln_b, w_in_ab, q_norm_g, w_q_up,
              kv_norm_g, w_kv_up, sgu_norm_g, sgu_norm_b, sgu_w, sgu_b, w_out_ab,
              ffn_w_gate, ffn_w_up, ffn_w_down, pool_w, pool_scale, w_out_c, router_w,
              moe_w_gate, moe_w_up, moe_w_down):
    cos, sin = rope_tables(positions)
    for l in range(DEPTH):
        j = l // 2
        shift, scale, gate = ada_modulation(c, ada_w[l, 0], ada_b[l, 0])
        hm = x * (1 + scale) + shift
        if l % 2 == 0:
            y = mixer_ab(hm, cos, sin, w_in_ab[j], q_norm_g[j], w_q_up[j], kv_norm_g[j], w_kv_up[j],
                         sgu_norm_g[j], sgu_norm_b[j], sgu_w[j], sgu_b[j], w_out_ab[j])
        else:
            y = multiscale_pool(hm, pool_w[j], pool_scale[j]) @ w_out_c[j]
        x = layer_norm(DEEPNORM_ALPHA * x + (1 + gate) * y, ln_g[l, 0], ln_b[l, 0])
        shift, scale, gate = ada_modulation(c, ada_w[l, 1], ada_b[l, 1])
        hm = x * (1 + scale) + shift
        if l % 2 == 0:
            y = swiglu(hm, ffn_w_gate[j], ffn_w_up[j], ffn_w_down[j])
        else:
            y = moe_swiglu(hm, router_w[j], moe_w_gate[j], moe_w_up[j], moe_w_down[j])
        x = layer_norm(DEEPNORM_ALPHA * x + (1 + gate) * y, ln_g[l, 1], ln_b[l, 1])
    return x
```

```cpp
#include <hip/hip_runtime.h>
#include <cstdio>
#include <cstdint>

namespace {
constexpr int D = 2048, NB = 2, S = 4096, T = NB * S, DEPTH = 4;
constexpr int NH = 8, DN = 128, DR = 64, DV = 128, QL = 768, KVL = 512;
constexpr int SGW = 1024, CH = 128, NG = 8, GD = 128;
constexpr int INW = 3392, QW = NH * (DN + DR)  , KVW = NH * (DN + DV)  ;
constexpr int FF = 5632, NE = 8, FE = 2816;
constexpr float ALPHA = 1.681792830507429f;
constexpr float LN_EPS = 1e-5f, RMS_EPS = 1e-6f;
constexpr int MPAD = 2 * T + NE * 128;
constexpr int MTILES = MPAD / 128;

__device__ const double ROPE_INV[32] = {1.0, 0.7498942093324559, 0.5623413251903491, 0.4216965034285822, 0.31622776601683794, 0.23713737056616552, 0.1778279410038923, 0.1333521432163324, 0.1, 0.07498942093324558, 0.05623413251903491, 0.042169650342858224, 0.03162277660168379, 0.023713737056616554, 0.01778279410038923, 0.01333521432163324, 0.01, 0.007498942093324558, 0.005623413251903491, 0.004216965034285823, 0.0031622776601683794, 0.0023713737056616554, 0.0017782794100389228, 0.001333521432163324, 0.001, 0.0007498942093324559, 0.0005623413251903491, 0.00042169650342858224, 0.00031622776601683794, 0.00023713737056616554, 0.00017782794100389227, 0.0001333521432163324};

__device__ __forceinline__ float silu_f(float v) { return v / (1.f + __expf(-v)); }
__device__ __forceinline__ float gelu_tanh_f(float v) { const float y = 0.7978845608028654f * (v + 0.044715f * v * v * v); const float t = 1.f - 2.f / (1.f + __expf(2.f * y)); return 0.5f * v * (1.f + t); }

__device__ __forceinline__ float block_sum(float v, float* red) {
    for (int o = 32; o > 0; o >>= 1) v += __shfl_xor(v, o);
    __syncthreads();
    if ((threadIdx.x & 63) == 0) red[threadIdx.x >> 6] = v;
    __syncthreads();
    return red[0] + red[1] + red[2] + red[3];
}
__device__ __forceinline__ float block_max(float v, float* red) {
    for (int o = 32; o > 0; o >>= 1) v = fmaxf(v, __shfl_xor(v, o));
    __syncthreads();
    if ((threadIdx.x & 63) == 0) red[threadIdx.x >> 6] = v;
    __syncthreads();
    return fmaxf(fmaxf(red[0], red[1]), fmaxf(red[2], red[3]));
}

__global__ __launch_bounds__(256) void k_ada(const float* __restrict__ c, const float* __restrict__ w, const float* __restrict__ b, float* __restrict__ mod) {
    __shared__ float sc[2][D];
    const int tid = threadIdx.x, n = blockIdx.x * 256 + tid, ls = blockIdx.y;
    for (int i = tid; i < 2 * D; i += 256) sc[i / D][i % D] = silu_f(c[i]);
    __syncthreads();
    const float* wp = w + (size_t)ls * D * 3 * D + n;
    float a0 = 0.f, a1 = 0.f;
    for (int k = 0; k < D; ++k) { const float wv = wp[(size_t)k * 3 * D]; a0 += sc[0][k] * wv; a1 += sc[1][k] * wv; }
    const float bb = b[(size_t)ls * 3 * D + n];
    mod[((size_t)ls * 2 + 0) * 3 * D + n] = a0 + bb; mod[((size_t)ls * 2 + 1) * 3 * D + n] = a1 + bb;
}
__global__ void k_rope_tab(const int* __restrict__ pos, float* __restrict__ cs, float* __restrict__ sn) {
    const int i = blockIdx.x * blockDim.x + threadIdx.x; if (i >= T * 32) return;
    const int t = i >> 5, f = i & 31;
    const double ang = (double)pos[t] * ROPE_INV[f];
    const double kq = rint(ang * 0.6366197723675814); const double r = ang - kq * 1.5707963267948966; const double r2 = r * r;
    const double sr = r * (1.0 + r2 * (-1.0 / 6 + r2 * (1.0 / 120 + r2 * (-1.0 / 5040 + r2 * (1.0 / 362880 + r2 * (-1.0 / 39916800 + r2 * (1.0 / 6227020800.0)))))));
    const double cr = 1.0 + r2 * (-0.5 + r2 * (1.0 / 24 + r2 * (-1.0 / 720 + r2 * (1.0 / 40320 + r2 * (-1.0 / 3628800 + r2 * (1.0 / 479001600.0))))));
    const int q = ((int)kq) & 3;
    const double s = (q == 0) ? sr : (q == 1) ? cr : (q == 2) ? -sr : -cr;
    const double c = (q == 0) ? cr : (q == 1) ? -sr : (q == 2) ? -cr : sr;
    cs[i] = (float)c; sn[i] = (float)s;
}
__global__ void k_modulate(const float* __restrict__ x, const float* __restrict__ mod, float* __restrict__ hm) {
    const size_t i = (size_t)blockIdx.x * blockDim.x + threadIdx.x; if (i >= (size_t)T * D) return;
    const int t = (int)(i / D), d = (int)(i % D), b = t / S; const float* m = mod + (size_t)b * 3 * D;
    hm[i] = x[i] * (1.f + m[D + d]) + m[d];
}
template <int MODE>
__global__ __launch_bounds__(256) void k_gemm(const float* __restrict__ A, int lda, const float* __restrict__ W, int ldw, float* __restrict__ C, int ldc, int K,
                                              const int* __restrict__ rowidx, const int* __restrict__ tile_e, size_t wstride) {
    __shared__ __attribute__((aligned(16))) float As[16][132];
    __shared__ __attribute__((aligned(16))) float Bs[16][68];
    const int tid = threadIdx.x, m0 = blockIdx.y * 128, n0 = blockIdx.x * 64;
    if (MODE != 0) { const int e = tile_e[blockIdx.y]; if (e < 0) return; W += (size_t)e * wstride; }
    const int arow = tid >> 2, akq = tid & 3;
    int g0 = m0 + arow, g1 = m0 + arow + 64;
    if (MODE == 1) { int t0 = rowidx[g0], t1 = rowidx[g1]; g0 = t0 < 0 ? 0 : t0; g1 = t1 < 0 ? 0 : t1; }
    const float* ap0 = A + (size_t)g0 * lda + akq * 4; const float* ap1 = A + (size_t)g1 * lda + akq * 4;
    const float* bp = W + (size_t)(tid >> 4) * ldw + n0 + (tid & 15) * 4;
    const int ty = tid >> 4, tx = tid & 15;
    float acc[8][4];
#pragma unroll
    for (int i = 0; i < 8; ++i)
#pragma unroll
        for (int j = 0; j < 4; ++j) acc[i][j] = 0.f;
    for (int k0 = 0; k0 < K; k0 += 16) {
        const float4 a0 = *(const float4*)(ap0 + k0), a1 = *(const float4*)(ap1 + k0);
        const float4 bv = *(const float4*)(bp + (size_t)k0 * ldw);
        __syncthreads();
        As[akq * 4 + 0][arow] = a0.x; As[akq * 4 + 1][arow] = a0.y; As[akq * 4 + 2][arow] = a0.z; As[akq * 4 + 3][arow] = a0.w;
        As[akq * 4 + 0][arow + 64] = a1.x; As[akq * 4 + 1][arow + 64] = a1.y; As[akq * 4 + 2][arow + 64] = a1.z; As[akq * 4 + 3][arow + 64] = a1.w;
        *(float4*)&Bs[tid >> 4][(tid & 15) * 4] = bv;
        __syncthreads();
#pragma unroll
        for (int kk = 0; kk < 16; ++kk) {
            const float4 x0 = *(const float4*)&As[kk][ty * 8], x1 = *(const float4*)&As[kk][ty * 8 + 4], y = *(const float4*)&Bs[kk][tx * 4];
            const float xa[8] = {x0.x, x0.y, x0.z, x0.w, x1.x, x1.y, x1.z, x1.w}; const float ya[4] = {y.x, y.y, y.z, y.w};
#pragma unroll
            for (int i = 0; i < 8; ++i)
#pragma unroll
                for (int j = 0; j < 4; ++j) acc[i][j] += xa[i] * ya[j];
        }
    }
#pragma unroll
    for (int i = 0; i < 8; ++i) *(float4*)(C + (size_t)(m0 + ty * 8 + i) * ldc + n0 + tx * 4) = make_float4(acc[i][0], acc[i][1], acc[i][2], acc[i][3]);
}
__global__ __launch_bounds__(256) void k_rms(const float* __restrict__ z, int ldz, int c0, int w, const float* __restrict__ g, float* __restrict__ out) {
    __shared__ float red[4];
    const int t = blockIdx.x; const float* zr = z + (size_t)t * ldz + c0;
    float s = 0.f; for (int i = threadIdx.x; i < w; i += 256) { const float v = zr[i]; s += v * v; }
    s = block_sum(s, red);
    const float r = 1.f / sqrtf(s / (float)w + RMS_EPS);
    for (int i = threadIdx.x; i < w; i += 256) out[(size_t)t * w + i] = zr[i] * r * g[i];
}
__global__ void k_rope_q(float* __restrict__ q, const float* __restrict__ cs, const float* __restrict__ sn) {
    const int i = blockIdx.x * blockDim.x + threadIdx.x; if (i >= T * NH * 32) return;
    const int f = i & 31, h = (i >> 5) & 7, t = i >> 8;
    float* p = q + (size_t)t * QW + h * (DN + DR) + DN; const float c = cs[t * 32 + f], s = sn[t * 32 + f];
    const float x1 = p[f], x2 = p[f + 32]; p[f] = x1 * c - x2 * s; p[f + 32] = x1 * s + x2 * c;
}
__global__ void k_rope_k(const float* __restrict__ z, float* __restrict__ kr, const float* __restrict__ cs, const float* __restrict__ sn) {
    const int i = blockIdx.x * blockDim.x + threadIdx.x; if (i >= T * 32) return;
    const int f = i & 31, t = i >> 5; const float* p = z + (size_t)t * INW + QL + KVL; const float c = cs[i], s = sn[i];
    const float x1 = p[f], x2 = p[f + 32]; kr[t * 64 + f] = x1 * c - x2 * s; kr[t * 64 + f + 32] = x1 * s + x2 * c;
}
__global__ __launch_bounds__(256) void k_sgu_pre(const float* __restrict__ z, const float* __restrict__ ng, const float* __restrict__ nbias, float* __restrict__ u, float* __restrict__ vg) {
    const int w = (blockIdx.x * 256 + threadIdx.x) >> 6, lane = threadIdx.x & 63; if (w >= T * NG) return;
    const int t = w >> 3, g = w & 7; const float* zu = z + (size_t)t * INW + QL + KVL + DR + g * GD; const float* zv = zu + SGW;
    u[(size_t)t * SGW + g * GD + lane] = gelu_tanh_f(zu[lane]); u[(size_t)t * SGW + g * GD + lane + 64] = gelu_tanh_f(zu[lane + 64]);
    const float a = gelu_tanh_f(zv[lane]), b = gelu_tanh_f(zv[lane + 64]);
    float s = a + b; for (int o = 32; o > 0; o >>= 1) s += __shfl_xor(s, o);
    const float mu = s * (1.f / GD); const float da = a - mu, db = b - mu;
    float q = da * da + db * db; for (int o = 32; o > 0; o >>= 1) q += __shfl_xor(q, o);
    const float r = 1.f / sqrtf(q * (1.f / GD) + LN_EPS);
    vg[(size_t)t * SGW + g * GD + lane] = da * r * ng[g * GD + lane] + nbias[g * GD + lane];
    vg[(size_t)t * SGW + g * GD + lane + 64] = db * r * ng[g * GD + lane + 64] + nbias[g * GD + lane + 64];
}
__global__ __launch_bounds__(128) void k_sgu_mix(const float* __restrict__ u, const float* __restrict__ vg, const float* __restrict__ w, const float* __restrict__ bs, float* __restrict__ cat) {
    const int t = blockIdx.x >> 3, g = blockIdx.x & 7, c = threadIdx.x, tl = t & (CH - 1), t0 = t - tl;
    const float* wr = w + ((size_t)g * CH + tl) * CH; float acc = 0.f;
    for (int s = 0; s <= tl; ++s) acc += wr[s] * vg[(size_t)(t0 + s) * SGW + g * GD + c];
    cat[(size_t)t * 2048 + 1024 + g * GD + c] = u[(size_t)t * SGW + g * GD + c] * (acc + bs[g * CH + tl]);
}
__global__ __launch_bounds__(256) void k_attn(const float* __restrict__ q, const float* __restrict__ kv, const float* __restrict__ kr, float* __restrict__ cat) {
    __shared__ float qs[192]; __shared__ float sc[S]; __shared__ float red[4]; __shared__ float part[128];
    const int tid = threadIdx.x, qi = blockIdx.x % S, h = (blockIdx.x / S) % NH, b = blockIdx.x / (S * NH);
    const size_t row0 = (size_t)b * S;
    if (tid < 192) qs[tid] = q[(row0 + qi) * QW + h * 192 + tid];
    __syncthreads();
    const int n = qi + 1; float mx = -1e30f;
    for (int k = tid; k < n; k += 256) {
        const float* kn = kv + (row0 + k) * KVW + h * 256; const float* kp = kr + (row0 + k) * 64; float dot = 0.f;
        for (int d = 0; d < 128; d += 4) { const float4 v = *(const float4*)(kn + d); dot += qs[d] * v.x + qs[d + 1] * v.y + qs[d + 2] * v.z + qs[d + 3] * v.w; }
        for (int d = 0; d < 64; d += 4) { const float4 v = *(const float4*)(kp + d); dot += qs[128 + d] * v.x + qs[129 + d] * v.y + qs[130 + d] * v.z + qs[131 + d] * v.w; }
        dot *= 0.07216878364870322f; sc[k] = dot; mx = fmaxf(mx, dot);
    }
    mx = block_max(mx, red);
    float sum = 0.f;
    for (int k = tid; k < n; k += 256) { const float p = __expf(sc[k] - mx); sc[k] = p; sum += p; }
    sum = block_sum(sum, red);
    const int d = tid & 127, half = tid >> 7; float acc = 0.f;
    for (int k = half; k < n; k += 2) acc += sc[k] * kv[(row0 + k) * KVW + h * 256 + 128 + d];
    if (half == 1) part[d] = acc;
    __syncthreads();
    if (half == 0) cat[(row0 + qi) * 2048 + h * 128 + d] = (acc + part[d]) / sum;
}
__global__ __launch_bounds__(256) void k_deepnorm(const float* x, const float* __restrict__ y, const float* __restrict__ mod, const float* __restrict__ g, const float* __restrict__ bb, float* out) {
    __shared__ float red[4];
    const int t = blockIdx.x, b = t / S; const float* gate = mod + (size_t)b * 3 * D + 2 * D;
    float v[8]; float s = 0.f;
#pragma unroll
    for (int i = 0; i < 8; ++i) { const int d = threadIdx.x + i * 256; v[i] = ALPHA * x[(size_t)t * D + d] + (1.f + gate[d]) * y[(size_t)t * D + d]; s += v[i]; }
    const float mu = block_sum(s, red) * (1.f / D); float qq = 0.f;
#pragma unroll
    for (int i = 0; i < 8; ++i) { v[i] -= mu; qq += v[i] * v[i]; }
    const float r = 1.f / sqrtf(block_sum(qq, red) * (1.f / D) + LN_EPS);
#pragma unroll
    for (int i = 0; i < 8; ++i) { const int d = threadIdx.x + i * 256; out[(size_t)t * D + d] = v[i] * r * g[d] + bb[d]; }
}
__global__ void k_swiglu(float* __restrict__ g, const float* __restrict__ u, size_t n) {
    const size_t i = (size_t)blockIdx.x * blockDim.x + threadIdx.x; if (i >= n) return; g[i] = silu_f(g[i]) * u[i];
}
__global__ void k_pool(const float* __restrict__ hm, float* __restrict__ pd) {
    const size_t i = (size_t)blockIdx.x * blockDim.x + threadIdx.x; if (i >= (size_t)T * D) return;
    const int t = (int)(i / D), d = (int)(i % D), tl = t % S, w = 2 << (d / 512);
    const int cnt = (tl + 1 < w) ? tl + 1 : w; float s = 0.f;
    for (int j = 0; j < cnt; ++j) s += hm[i - (size_t)j * D];
    pd[i] = s / (float)cnt - hm[i];
}
__global__ void k_colscale(float* __restrict__ p, const float* __restrict__ sc) {
    const size_t i = (size_t)blockIdx.x * blockDim.x + threadIdx.x; if (i >= (size_t)T * D) return; p[i] *= sc[i % D];
}
__global__ __launch_bounds__(256) void k_router(const float* __restrict__ hm, const float* __restrict__ rw, int* __restrict__ top_i, float* __restrict__ top_w) {
    const int t = (blockIdx.x * 256 + threadIdx.x) >> 6, lane = threadIdx.x & 63; if (t >= T) return;
    float lg[NE];
#pragma unroll
    for (int e = 0; e < NE; ++e) lg[e] = 0.f;
    for (int d = lane; d < D; d += 64) { const float v = hm[(size_t)t * D + d]; const float4 r0 = *(const float4*)(rw + (size_t)d * NE), r1 = *(const float4*)(rw + (size_t)d * NE + 4);
        lg[0] += v * r0.x; lg[1] += v * r0.y; lg[2] += v * r0.z; lg[3] += v * r0.w; lg[4] += v * r1.x; lg[5] += v * r1.y; lg[6] += v * r1.z; lg[7] += v * r1.w; }
#pragma unroll
    for (int e = 0; e < NE; ++e) for (int o = 32; o > 0; o >>= 1) lg[e] += __shfl_xor(lg[e], o);
    int i1 = 0; float v1 = lg[0];
#pragma unroll
    for (int e = 1; e < NE; ++e) if (lg[e] > v1) { v1 = lg[e]; i1 = e; }
    int i2 = -1; float v2 = -3.4e38f;
#pragma unroll
    for (int e = 0; e < NE; ++e) if (e != i1 && lg[e] > v2) { v2 = lg[e]; i2 = e; }
    if (lane == 0) { const float w2 = 1.f / (1.f + __expf(v1 - v2)); top_i[t * 2] = i1; top_i[t * 2 + 1] = i2; top_w[t * 2] = 1.f - w2; top_w[t * 2 + 1] = w2; }
}
__global__ __launch_bounds__(64) void k_sort(const int* __restrict__ top_i, int* __restrict__ rowidx, int* __restrict__ tile_e, int* __restrict__ pos) {
    __shared__ int cnt[NE]; __shared__ int start[NE + 1];
    const int e = threadIdx.x;
    for (int i = e; i < MPAD; i += 64) rowidx[i] = -1;
    for (int i = e; i < MTILES; i += 64) tile_e[i] = -1;
    __syncthreads();
    if (e < NE) { int c = 0; for (int p = 0; p < 2 * T; ++p) c += (top_i[p] == e); cnt[e] = c; }
    __syncthreads();
    if (e == 0) { int s = 0; for (int k = 0; k < NE; ++k) { start[k] = s; s += (cnt[k] + 127) / 128 * 128; } start[NE] = s; }
    __syncthreads();
    if (e < NE) { int o = start[e]; for (int p = 0; p < 2 * T; ++p) if (top_i[p] == e) { rowidx[o] = p >> 1; pos[p] = o; ++o; }
        for (int tl = start[e] / 128; tl < start[e + 1] / 128; ++tl) tile_e[tl] = e; }
}
__global__ void k_moe_combine(const float* __restrict__ ys, const int* __restrict__ pos, const float* __restrict__ top_w, float* __restrict__ y) {
    const size_t i = (size_t)blockIdx.x * blockDim.x + threadIdx.x; if (i >= (size_t)T * D) return;
    const int t = (int)(i / D), d = (int)(i % D);
    y[i] = top_w[t * 2] * ys[(size_t)pos[t * 2] * D + d] + top_w[t * 2 + 1] * ys[(size_t)pos[t * 2 + 1] * D + d];
}

template <int MODE>
void gemm(hipStream_t st, const float* A, int lda, const float* W, int ldw, float* C, int ldc, int M, int N, int K, const int* rowidx = nullptr, const int* tile_e = nullptr, size_t wstride = 0) {
    hipLaunchKernelGGL(k_gemm<MODE>, dim3(N / 64, M / 128), dim3(256), 0, st, A, lda, W, ldw, C, ldc, K, rowidx, tile_e, wstride);
}
}

extern "C" void kernel_launch(void* const* d_in, const int* in_sizes, int n_in, void* d_out, int out_size, void* d_ws, size_t ws_size, hipStream_t stream) {
    (void)in_sizes; (void)n_in; (void)out_size;
    const float* x_in = (const float*)d_in[0]; const float* c = (const float*)d_in[1]; const int* positions = (const int*)d_in[2];
    const float* ada_w = (const float*)d_in[3]; const float* ada_b = (const float*)d_in[4]; const float* ln_g = (const float*)d_in[5]; const float* ln_b = (const float*)d_in[6];
    const float* w_in_ab = (const float*)d_in[7]; const float* q_norm_g = (const float*)d_in[8]; const float* w_q_up = (const float*)d_in[9]; const float* kv_norm_g = (const float*)d_in[10];
    const float* w_kv_up = (const float*)d_in[11]; const float* sgu_norm_g = (const float*)d_in[12]; const float* sgu_norm_b = (const float*)d_in[13]; const float* sgu_w = (const float*)d_in[14];
    const float* sgu_b = (const float*)d_in[15]; const float* w_out_ab = (const float*)d_in[16]; const float* ffn_w_gate = (const float*)d_in[17]; const float* ffn_w_up = (const float*)d_in[18];
    const float* ffn_w_down = (const float*)d_in[19]; const float* pool_w = (const float*)d_in[20]; const float* pool_scale = (const float*)d_in[21]; const float* w_out_c = (const float*)d_in[22];
    const float* router_w = (const float*)d_in[23]; const float* moe_w_gate = (const float*)d_in[24]; const float* moe_w_up = (const float*)d_in[25]; const float* moe_w_down = (const float*)d_in[26];
    float* ws = (float*)d_ws; size_t off = 0;
    auto take = [&](size_t n) { float* p = ws + off; off += (n + 63) / 64 * 64; return p; };
    float* MOD = take((size_t)8 * 2 * 3 * D); float* COS = take((size_t)T * 32); float* SIN = take((size_t)T * 32);
    float* X = take((size_t)T * D); float* HM = take((size_t)T * D); float* Y = take((size_t)T * D);
    int* TOPI = (int*)take((size_t)T * 2); float* TOPW = take((size_t)T * 2); int* ROWIDX = (int*)take(MPAD); int* TILEE = (int*)take(MTILES); int* POS = (int*)take((size_t)T * 2);
    float* ARENA = ws + off;
    size_t ao = 0; auto atake = [&](size_t n) { float* p = ARENA + ao; ao += (n + 63) / 64 * 64; return p; };
    float* Z = atake((size_t)T * INW); float* CQN = atake((size_t)T * QL); float* CKVN = atake((size_t)T * KVL); float* Q = atake((size_t)T * QW); float* KV = atake((size_t)T * KVW);
    float* KR = atake((size_t)T * 64); float* U = atake((size_t)T * SGW); float* VG = atake((size_t)T * SGW); float* CAT = atake((size_t)T * 2048);
    float* HG = ARENA; float* HU = ARENA + (size_t)MPAD * FE; float* YS = ARENA + (size_t)2 * MPAD * FE;
    float* PD = ARENA; float* PP = ARENA + (size_t)T * D;
    static_assert((size_t)MPAD * FE >= (size_t)T * FF, "arena");
    const size_t need = (off + (size_t)2 * MPAD * FE + (size_t)MPAD * D) * 4;
    if (need > ws_size) { fprintf(stderr, "kernel_launch: workspace too small: need %zu have %zu\n", need, ws_size); return; }
    const int EB = 256; const unsigned gTD = (unsigned)(((size_t)T * D + EB - 1) / EB);

    hipMemcpyAsync(X, x_in, (size_t)T * D * 4, hipMemcpyDeviceToDevice, stream);
    hipLaunchKernelGGL(k_ada, dim3(3 * D / 256, 8), dim3(256), 0, stream, c, ada_w, ada_b, MOD);
    hipLaunchKernelGGL(k_rope_tab, dim3(T * 32 / 256), dim3(256), 0, stream, positions, COS, SIN);
    for (int l = 0; l < DEPTH; ++l) {
        const int j = l / 2; const float* mod0 = MOD + (size_t)(l * 2 + 0) * 2 * 3 * D; const float* mod1 = MOD + (size_t)(l * 2 + 1) * 2 * 3 * D;
        hipLaunchKernelGGL(k_modulate, dim3(gTD), dim3(EB), 0, stream, X, mod0, HM);
        if ((l & 1) == 0) {
            gemm<0>(stream, HM, D, w_in_ab + (size_t)j * D * INW, INW, Z, INW, T, INW, D);
            hipLaunchKernelGGL(k_rms, dim3(T), dim3(256), 0, stream, Z, INW, 0, QL, q_norm_g + j * QL, CQN);
            hipLaunchKernelGGL(k_rms, dim3(T), dim3(256), 0, stream, Z, INW, QL, KVL, kv_norm_g + j * KVL, CKVN);
            gemm<0>(stream, CQN, QL, w_q_up + (size_t)j * QL * QW, QW, Q, QW, T, QW, QL);
            hipLaunchKernelGGL(k_rope_q, dim3(T * NH * 32 / 256), dim3(256), 0, stream, Q, COS, SIN);
            gemm<0>(stream, CKVN, KVL, w_kv_up + (size_t)j * KVL * KVW, KVW, KV, KVW, T, KVW, KVL);
            hipLaunchKernelGGL(k_rope_k, dim3(T * 32 / 256), dim3(256), 0, stream, Z, KR, COS, SIN);
            hipLaunchKernelGGL(k_attn, dim3(NB * NH * S), dim3(256), 0, stream, Q, KV, KR, CAT);
            hipLaunchKernelGGL(k_sgu_pre, dim3(T * NG * 64 / 256), dim3(256), 0, stream, Z, sgu_norm_g + j * SGW, sgu_norm_b + j * SGW, U, VG);
            hipLaunchKernelGGL(k_sgu_mix, dim3(T * NG), dim3(128), 0, stream, U, VG, sgu_w + (size_t)j * NG * CH * CH, sgu_b + j * NG * CH, CAT);
            gemm<0>(stream, CAT, 2048, w_out_ab + (size_t)j * 2048 * D, D, Y, D, T, D, 2048);
        } else {
            hipLaunchKernelGGL(k_pool, dim3(gTD), dim3(EB), 0, stream, HM, PD);
            for (int gi = 0; gi < 4; ++gi) gemm<0>(stream, PD + gi * 512, D, pool_w + ((size_t)j * 4 + gi) * 512 * 512, 512, PP + gi * 512, D, T, 512, 512);
            hipLaunchKernelGGL(k_colscale, dim3(gTD), dim3(EB), 0, stream, PP, pool_scale + j * D);
            gemm<0>(stream, PP, D, w_out_c + (size_t)j * D * D, D, Y, D, T, D, D);
        }
        hipLaunchKernelGGL(k_deepnorm, dim3(T), dim3(256), 0, stream, X, Y, mod0, ln_g + (size_t)(l * 2) * D, ln_b + (size_t)(l * 2) * D, X);
        hipLaunchKernelGGL(k_modulate, dim3(gTD), dim3(EB), 0, stream, X, mod1, HM);
        if ((l & 1) == 0) {
            gemm<0>(stream, HM, D, ffn_w_gate + (size_t)j * D * FF, FF, HG, FF, T, FF, D);
            gemm<0>(stream, HM, D, ffn_w_up + (size_t)j * D * FF, FF, HU, FF, T, FF, D);
            hipLaunchKernelGGL(k_swiglu, dim3((unsigned)(((size_t)T * FF + EB - 1) / EB)), dim3(EB), 0, stream, HG, HU, (size_t)T * FF);
            gemm<0>(stream, HG, FF, ffn_w_down + (size_t)j * FF * D, D, Y, D, T, D, FF);
        } else {
            hipLaunchKernelGGL(k_router, dim3(T * 64 / 256), dim3(256), 0, stream, HM, router_w + (size_t)j * D * NE, TOPI, TOPW);
            hipLaunchKernelGGL(k_sort, dim3(1), dim3(64), 0, stream, TOPI, ROWIDX, TILEE, POS);
            gemm<1>(stream, HM, D, moe_w_gate + (size_t)j * NE * D * FE, FE, HG, FE, MPAD, FE, D, ROWIDX, TILEE, (size_t)D * FE);
            gemm<1>(stream, HM, D, moe_w_up + (size_t)j * NE * D * FE, FE, HU, FE, MPAD, FE, D, ROWIDX, TILEE, (size_t)D * FE);
            hipLaunchKernelGGL(k_swiglu, dim3((unsigned)(((size_t)MPAD * FE + EB - 1) / EB)), dim3(EB), 0, stream, HG, HU, (size_t)MPAD * FE);
            gemm<2>(stream, HG, FE, moe_w_down + (size_t)j * NE * FE * D, D, YS, D, MPAD, D, FE, nullptr, TILEE, (size_t)FE * D);
            hipLaunchKernelGGL(k_moe_combine, dim3(gTD), dim3(EB), 0, stream, YS, POS, TOPW, Y);
        }
        float* xo = (l == DEPTH - 1) ? (float*)d_out : X;
        hipLaunchKernelGGL(k_deepnorm, dim3(T), dim3(256), 0, stream, X, Y, mod1, ln_g + (size_t)(l * 2 + 1) * D, ln_b + (size_t)(l * 2 + 1) * D, xo);
    }
}
```

```cpp
#include <hip/hip_runtime.h>
#include <cstdio>
#include <cstdint>
#define MEGA_PHASES 32
#define MEGA_ONE_LAUNCH 1
namespace {
constexpr int D = 2048, NB = 2, S = 4096, T = NB * S, DEPTH = 4;
constexpr int NH = 8, DN = 128, DR = 64, DV = 128, QL = 768, KVL = 512;
constexpr int SGW = 1024, CH = 128, NG = 8, GD = 128;
constexpr int INW = 3392, INWP = 3584, QW = NH * (DN + DR)  , KVW = NH * (DN + DV)  ;
constexpr int FF = 5632, NE = 8, FE = 2816;
constexpr float ALPHA = 1.681792830507429f;
constexpr float LN_EPS = 1e-5f, RMS_EPS = 1e-6f;
constexpr int CAP = T;
}

namespace pg8 {
#define PG8_LAS __attribute__((address_space(3)))
typedef unsigned short bf16_t;
typedef short bf16x8 __attribute__((ext_vector_type(8)));
typedef float f32x4 __attribute__((ext_vector_type(4)));
typedef float f32x2 __attribute__((ext_vector_type(2)));
typedef unsigned u32x4 __attribute__((ext_vector_type(4)));
typedef unsigned u32x2 __attribute__((ext_vector_type(2)));
constexpr int BM = 256, BK = 64, HALF = 128, HTB = HALF * BK * 2  , STAGE_BYTES = 8 * HTB, NXCD = 8, WGM = 8;

__host__ __device__ __forceinline__ int lds_byte(int r, int c) { const int st = (r >> 4) * 2 + (c >> 5), rr = r & 15, cc = c & 31, ob = rr * 64 + cc * 2; return st * 1024 + (ob ^ (((ob >> 9) & 1) << 5)); }
__host__ __device__ __forceinline__ void stage_rc(int b, int& R, int& C) { const int st = b / 1024, sb = b % 1024, swz = sb ^ (((sb >> 9) & 1) << 5); R = (st >> 1) * 16 + swz / 64; C = (st & 1) * 32 + (swz % 64) / 2; }
__host__ __device__ __forceinline__ int perm32(int rho) { const int n = rho >> 4, i = rho & 15; return 8 * (i >> 2) + 4 * n + (i & 3); }

struct Unit { int pm, pn; const char* A; const char* B; int aux; };

__device__ __forceinline__ int xcd_remap(int L, int nwg) { const int q = nwg / NXCD, r = nwg % NXCD, xcd = L % NXCD, off = L / NXCD; return (xcd < r ? xcd * (q + 1) : r * (q + 1) + (xcd - r) * q) + off; }

struct StaticOrder {
    int nM, nN, nwg, G, c; const char* A; const char* B; int lda, ldb; int a_shift, a_cols;
    __device__ void init(int M, int N, int G_, int c_, const void* A_, int lda_, const void* B_, int ldb_, int a_shift_ = 0, int a_cols_ = 0) {
        nM = M / BM; nN = N / BM; nwg = nM * nN; G = G_; c = c_; A = (const char*)A_; B = (const char*)B_; lda = lda_; ldb = ldb_; a_shift = a_shift_; a_cols = a_cols_; }
    __device__ bool next(int i, Unit& u) const {
        const long L = (long)i * G + c; if (L >= nwg) return false;
        const int wgid = xcd_remap((int)L, nwg);
        const int nig = WGM * nN, gid = wgid / nig, fm = gid * WGM, gsz = (nM - fm) < WGM ? (nM - fm) : WGM;
        u.pm = fm + ((wgid % nig) % gsz); u.pn = (wgid % nig) / gsz; u.aux = 0;
        u.A = A + ((size_t)u.pm * BM * lda + (size_t)((u.pn >> a_shift) * a_cols)) * 2; u.B = B + (size_t)u.pn * BM * ldb * 2; return true;
    }
};
struct MoeOrder {
    const PG8_LAS int* tab; int ncol, G, c; const char* A; const char* B; int lda, ldb; size_t bstride;
    __device__ bool next(int i, Unit& u) const {
        const int nwg = __builtin_amdgcn_readfirstlane(tab[8]); const long L = (long)i * G + c; if (L >= nwg) return false;
        const int id = xcd_remap((int)L, nwg);
        int e = 0;
#pragma unroll
        for (int k = 1; k < 8; ++k) e += (id >= __builtin_amdgcn_readfirstlane(tab[k])) ? 1 : 0;
        const int idx = id - __builtin_amdgcn_readfirstlane(tab[e]), nr = __builtin_amdgcn_readfirstlane(tab[9 + e]), rt = idx % nr, pn = idx / nr;
        u.pm = e * (CAP / BM) + rt; u.pn = pn; u.aux = e;
        u.A = A + (size_t)u.pm * BM * lda * 2; u.B = B + (size_t)e * bstride + (size_t)pn * BM * ldb * 2; return true;
    }
};

__device__ __forceinline__ int launder(int v) { asm volatile("" : "+v"(v)); return v; }
__device__ __forceinline__ unsigned cvt_pk_bf16(float lo, float hi) { unsigned r; asm volatile("v_cvt_pk_bf16_f32 %0, %1, %2" : "=v"(r) : "v"(lo), "v"(hi)); return r; }
__device__ __forceinline__ float silu_f(float v) { return v * __builtin_amdgcn_rcpf(1.f + __builtin_amdgcn_exp2f(-1.4426950408889634f * v)); }
__device__ __forceinline__ float gelu_tanh_f(float v) { const float y = 0.7978845608028654f * (v + 0.044715f * v * v * v); return v * __builtin_amdgcn_rcpf(1.f + __builtin_amdgcn_exp2f(-2.8853900817779268f * y)); }

typedef f32x4 Acc[2][2][4][2];
__device__ __forceinline__ u32x4 pack8(f32x4 v0, f32x4 v1) { u32x4 w; w.x = cvt_pk_bf16(v0[0], v0[1]); w.y = cvt_pk_bf16(v0[2], v0[3]); w.z = cvt_pk_bf16(v1[0], v1[1]); w.w = cvt_pk_bf16(v1[2], v1[3]); return w; }

struct EpiIn {
    static constexpr bool PERM = true;
    bf16_t* CQ; bf16_t* CKV; bf16_t* ZU; bf16_t* ZV; float* KRAW; float* SSQQ; float* SSQKV;
    __device__ __forceinline__ void operator()(const Acc& acc, const Unit& u, int wr, int wc, int fr, int fq) const {
        const int row0 = u.pm * BM + wr * 64 + fr, pn = u.pn;
        if (pn < 5) {
            const bool isq = pn < 3; const int pl = isq ? pn : pn - 3, ld = isq ? QL : KVL; bf16_t* base = (isq ? CQ : CKV) + pl * BM + wc * 32 + 8 * fq;
            float* sq = isq ? SSQQ : SSQKV; const int sld = isq ? 12 : 8;
#pragma unroll
            for (int ai = 0; ai < 2; ++ai)
#pragma unroll
                for (int m = 0; m < 4; ++m) { const int row = row0 + ai * HALF + m * 16; float s = 0.f;
#pragma unroll
                    for (int bj = 0; bj < 2; ++bj) { const f32x4 v0 = acc[ai][bj][m][0], v1 = acc[ai][bj][m][1];
                        s += (v0[0] * v0[0] + v0[1] * v0[1]) + (v0[2] * v0[2] + v0[3] * v0[3]) + (v1[0] * v1[0] + v1[1] * v1[1]) + (v1[2] * v1[2] + v1[3] * v1[3]);
                        *(u32x4*)(base + (size_t)row * ld + bj * HALF) = pack8(v0, v1); }
                    s += __shfl_xor(s, 16); s += __shfl_xor(s, 32);
                    if (fq == 0) sq[(size_t)row * sld + pl * 4 + wc] = s; asm volatile("" ::: "memory"); }
        } else if (pn < 13) {
            const bool isu = pn < 9; const int pl = isu ? pn - 5 : pn - 9; bf16_t* base = (isu ? ZU : ZV) + pl * BM + wc * 32 + 8 * fq;
#pragma unroll
            for (int ai = 0; ai < 2; ++ai)
#pragma unroll
                for (int m = 0; m < 4; ++m) { const int row = row0 + ai * HALF + m * 16;
#pragma unroll
                    for (int bj = 0; bj < 2; ++bj) { f32x4 v0 = acc[ai][bj][m][0], v1 = acc[ai][bj][m][1];
#pragma unroll
                        for (int e = 0; e < 4; ++e) { v0[e] = gelu_tanh_f(v0[e]); v1[e] = gelu_tanh_f(v1[e]); }
                        *(u32x4*)(base + (size_t)row * SGW + bj * HALF) = pack8(v0, v1); } asm volatile("" ::: "memory"); }
        } else {
            if (wc < 2) {
#pragma unroll
                for (int ai = 0; ai < 2; ++ai)
#pragma unroll
                    for (int m = 0; m < 4; ++m) { const int row = row0 + ai * HALF + m * 16; float* p = KRAW + (size_t)row * 64 + wc * 32 + 8 * fq;
                        *(f32x4*)p = acc[ai][0][m][0]; *(f32x4*)(p + 4) = acc[ai][0][m][1]; }
            }
        }
    }
};
__device__ __forceinline__ float row_rs(const float* p, int n4, float inv_n) {
    float s = 0.f;
#pragma unroll
    for (int i = 0; i < 3; ++i) if (i < n4) { const f32x4 v = *(const f32x4*)(p + 4 * i); s += (v[0] + v[1]) + (v[2] + v[3]); }
    return 1.f / sqrtf(s * inv_n + RMS_EPS);
}
struct EpiQ {
    static constexpr bool PERM = true;
    bf16_t* Q; const float* SSQQ; const float* COS; const float* SIN;
    __device__ __forceinline__ void operator()(const Acc& acc, const Unit& u, int wr, int wc, int fr, int fq) const {
        const int row0 = u.pm * BM + wr * 64 + fr, pn = u.pn;
#pragma unroll
        for (int ai = 0; ai < 2; ++ai)
#pragma unroll
            for (int m = 0; m < 4; ++m) { const int row = row0 + ai * HALF + m * 16; const float rs = row_rs(SSQQ + (size_t)row * 12, 3, 1.f / QL);
                if (pn < 4) {
#pragma unroll
                    for (int bj = 0; bj < 2; ++bj) *(u32x4*)(Q + (size_t)row * QW + (2 * pn + bj) * 192 + wc * 32 + 8 * fq) = pack8(acc[ai][bj][m][0] * rs, acc[ai][bj][m][1] * rs);
                } else {
                    const int head = (pn - 4) * 4 + wc; f32x4 o1[2], o2[2];
#pragma unroll
                    for (int n = 0; n < 2; ++n) { const f32x4 c = *(const f32x4*)(COS + (size_t)row * 32 + 8 * fq + 4 * n), s = *(const f32x4*)(SIN + (size_t)row * 32 + 8 * fq + 4 * n);
                        const f32x4 x1 = acc[ai][0][m][n] * rs, x2 = acc[ai][1][m][n] * rs; o1[n] = x1 * c - x2 * s; o2[n] = x1 * s + x2 * c; }
                    bf16_t* p = Q + (size_t)row * QW + head * 192 + 128 + 8 * fq;
                    *(u32x4*)p = pack8(o1[0], o1[1]); *(u32x4*)(p + 32) = pack8(o2[0], o2[1]);
                } asm volatile("" ::: "memory"); }
    }
};
struct EpiKV {
    static constexpr bool PERM = true;
    bf16_t* KV; const float* SSQKV;
    __device__ __forceinline__ void operator()(const Acc& acc, const Unit& u, int wr, int wc, int fr, int fq) const {
        const int row0 = u.pm * BM + wr * 64 + fr;
#pragma unroll
        for (int ai = 0; ai < 2; ++ai)
#pragma unroll
            for (int m = 0; m < 4; ++m) { const int row = row0 + ai * HALF + m * 16; const float rs = row_rs(SSQKV + (size_t)row * 8, 2, 1.f / KVL);
#pragma unroll
                for (int bj = 0; bj < 2; ++bj) *(u32x4*)(KV + (size_t)row * KVW + u.pn * BM + bj * HALF + wc * 32 + 8 * fq) = pack8(acc[ai][bj][m][0] * rs, acc[ai][bj][m][1] * rs); asm volatile("" ::: "memory"); }
    }
};
struct EpiRes {
    static constexpr bool PERM = false;
    const float* xres; const float* mod; float* V;
    __device__ __forceinline__ void operator()(const Acc& acc, const Unit& u, int wr, int wc, int fr, int fq) const {
        const int row0 = u.pm * BM + wr * 64 + fr, col0 = u.pn * BM + wc * 32 + 4 * fq; const float* gate = mod + (size_t)((u.pm * BM) / S) * 3 * D + 2 * D;
        f32x4 g[2][2];
#pragma unroll
        for (int bj = 0; bj < 2; ++bj)
#pragma unroll
            for (int n = 0; n < 2; ++n) g[bj][n] = *(const f32x4*)(gate + col0 + bj * HALF + n * 16) + 1.f;
#pragma unroll
        for (int ai = 0; ai < 2; ++ai)
#pragma unroll
            for (int m = 0; m < 4; ++m) { const size_t off = (size_t)(row0 + ai * HALF + m * 16) * D + col0;
#pragma unroll
                for (int bj = 0; bj < 2; ++bj)
#pragma unroll
                    for (int n = 0; n < 2; ++n) { const f32x4 xr = *(const f32x4*)(xres + off + bj * HALF + n * 16); *(f32x4*)(V + off + bj * HALF + n * 16) = xr * ALPHA + g[bj][n] * acc[ai][bj][m][n]; }
                if (m & 1) asm volatile("" ::: "memory"); }
    }
};
struct EpiSwiGLU {
    static constexpr bool PERM = true;
    bf16_t* H; int ldh;
    __device__ __forceinline__ void operator()(const Acc& acc, const Unit& u, int wr, int wc, int fr, int fq) const {
        const int row0 = u.pm * BM + wr * 64 + fr; bf16_t* base = H + u.pn * HALF + wc * 32 + 8 * fq;
#pragma unroll
        for (int ai = 0; ai < 2; ++ai)
#pragma unroll
            for (int m = 0; m < 4; ++m) { f32x4 h0, h1;
#pragma unroll
                for (int e = 0; e < 4; ++e) { h0[e] = silu_f(acc[ai][0][m][0][e]) * acc[ai][1][m][0][e]; h1[e] = silu_f(acc[ai][0][m][1][e]) * acc[ai][1][m][1][e]; }
                *(u32x4*)(base + (size_t)(row0 + ai * HALF + m * 16) * ldh) = pack8(h0, h1); }
    }
};
struct EpiScaleBf16 {
    static constexpr bool PERM = true;
    bf16_t* O; int ldo; const float* scale;
    __device__ __forceinline__ void operator()(const Acc& acc, const Unit& u, int wr, int wc, int fr, int fq) const {
        const int row0 = u.pm * BM + wr * 64 + fr, col0 = u.pn * BM + wc * 32 + 8 * fq;
        f32x4 sc[2][2];
#pragma unroll
        for (int bj = 0; bj < 2; ++bj)
#pragma unroll
            for (int n = 0; n < 2; ++n) sc[bj][n] = *(const f32x4*)(scale + col0 + bj * HALF + 4 * n);
#pragma unroll
        for (int ai = 0; ai < 2; ++ai)
#pragma unroll
            for (int m = 0; m < 4; ++m)
#pragma unroll
                for (int bj = 0; bj < 2; ++bj) *(u32x4*)(O + (size_t)(row0 + ai * HALF + m * 16) * ldo + col0 + bj * HALF) = pack8(acc[ai][bj][m][0] * sc[bj][0], acc[ai][bj][m][1] * sc[bj][1]);
    }
};
struct EpiMoeDown {
    static constexpr bool PERM = false;
    float* YS; const int* ROWTS; const float* ROWW; const unsigned* cnt;
    __device__ __forceinline__ void operator()(const Acc& acc, const Unit& u, int wr, int wc, int fr, int fq) const {
        const int e = u.aux, n = (int)cnt[64 * e], rl0 = (u.pm - e * (CAP / BM)) * BM + wr * 64 + fr, col0 = u.pn * BM + wc * 32 + 4 * fq;
#pragma unroll
        for (int ai = 0; ai < 2; ++ai)
#pragma unroll
            for (int m = 0; m < 4; ++m) { const int rl = rl0 + ai * HALF + m * 16;
                if (rl < n) { const size_t p = (size_t)e * CAP + rl; const int ts = ROWTS[p]; const float w = ROWW[p]; float* o = YS + (size_t)ts * D + col0;
#pragma unroll
                    for (int bj = 0; bj < 2; ++bj)
#pragma unroll
                        for (int nn = 0; nn < 2; ++nn) *(f32x4*)(o + bj * HALF + nn * 16) = acc[ai][bj][m][nn] * w; } }
    }
};

__device__ __forceinline__ void glds16s(const char* sbase, unsigned voff, unsigned lds_dst) {
    asm volatile("s_mov_b32 m0, %2\n\ts_nop 0\n\tglobal_load_lds_dwordx4 %0, %1" :: "v"(voff), "s"(sbase), "s"(lds_dst) : "memory");
}
template <class Epi, class Sched, bool ALIGN_EPI>
__device__ __forceinline__ void gemm_phase(PG8_LAS unsigned char* lds, const int K, const int lda, const int ldb, const Sched& S, const Epi& E) {
    const int tid = launder((int)threadIdx.x), wid = __builtin_amdgcn_readfirstlane(tid >> 6), lane = tid & 63, wr = wid >> 2, wc = wid & 3, fr = lane & 15, fq = lane >> 4;
    const int nt = K / BK;
    unsigned voffA[2], voffB[2];
#pragma unroll
    for (int i = 0; i < 2; ++i) { int R, C; stage_rc(tid * 16 + i * 8192, R, C); const int Rb = Epi::PERM ? ((R & ~31) + perm32(R & 31)) : R;
        voffA[i] = (unsigned)(R * lda + C) * 2u; voffB[i] = (unsigned)(Rb * ldb + C) * 2u; }
    const size_t kstep = (size_t)(BK * 2);
    const size_t hA = (size_t)HALF * lda * 2, hB = (size_t)HALF * ldb * 2;
    const unsigned ldsbase = (unsigned)(uintptr_t)lds + (unsigned)wid * 1024u;
    const int aoff = lds_byte(wr * 64 + fr, fq * 8), boff = lds_byte(wc * 32 + fr, fq * 8);
#define PG8_SA(b, h) (((b) * 2 + (h)) * HTB)
#define PG8_SB(b, h) ((4 + (b) * 2 + (h)) * HTB)
#define PG8_STAGE(bufoff, gbase, voff) do { _Pragma("unroll") for (int _i = 0; _i < 2; ++_i) \
        glds16s((const char*)(gbase), (voff)[_i], ldsbase + (unsigned)((bufoff) + _i * 8192)); } while (0)
#define PG8_LDA(dst, b, h) do { _Pragma("unroll") for (int m = 0; m < 4; ++m) _Pragma("unroll") for (int k = 0; k < 2; ++k) dst[m][k] = *(const PG8_LAS bf16x8*)(lds + PG8_SA(b, h) + aoff + m * 2048 + k * 1024); } while (0)
#define PG8_LDB(dst, b, h) do { _Pragma("unroll") for (int n = 0; n < 2; ++n) _Pragma("unroll") for (int k = 0; k < 2; ++k) dst[n][k] = *(const PG8_LAS bf16x8*)(lds + PG8_SB(b, h) + boff + n * 2048 + k * 1024); } while (0)
#define PG8_MMA(ai, bj, At, Bt) do { __builtin_amdgcn_s_setprio(1); _Pragma("unroll") for (int m = 0; m < 4; ++m) _Pragma("unroll") for (int n = 0; n < 2; ++n) _Pragma("unroll") for (int k = 0; k < 2; ++k) \
        acc[ai][bj][m][n] = __builtin_amdgcn_mfma_f32_16x16x32_bf16(Bt[n][k], At[m][k], acc[ai][bj][m][n], 0, 0, 0); __builtin_amdgcn_s_setprio(0); } while (0)
#define PG8_WAIT_V(n) asm volatile("s_waitcnt vmcnt(" #n ")" ::: "memory")
#define PG8_WAIT_L(n) asm volatile("s_waitcnt lgkmcnt(" #n ")" ::: "memory")
#define PG8_BAR __builtin_amdgcn_s_barrier()
#define PG8_SCHED __builtin_amdgcn_sched_barrier(0)
    Unit cur, nxt; int ui = 0;
    if (!S.next(0, cur)) return;
    f32x4 acc[2][2][4][2];
#pragma unroll
    for (int a = 0; a < 2; ++a)
#pragma unroll
        for (int b = 0; b < 2; ++b)
#pragma unroll
            for (int m = 0; m < 4; ++m)
#pragma unroll
                for (int n = 0; n < 2; ++n) acc[a][b][m][n] = (f32x4){0.f, 0.f, 0.f, 0.f};
    bf16x8 At[4][2], B0[2][2], B1[2][2];
    const char* cA = cur.A; const char* cB = cur.B;
    PG8_STAGE(PG8_SB(0, 0), cB, voffB); PG8_STAGE(PG8_SB(0, 1), cB + hB, voffB); PG8_STAGE(PG8_SA(0, 0), cA, voffA); PG8_STAGE(PG8_SA(0, 1), cA + hA, voffA);
    if (wr == 1) PG8_BAR;
    PG8_WAIT_V(2); PG8_BAR;
    PG8_STAGE(PG8_SB(1, 0), cB + kstep, voffB); PG8_STAGE(PG8_SA(1, 0), cA + kstep, voffA); PG8_STAGE(PG8_SB(1, 1), cB + hB + kstep, voffB);
    PG8_WAIT_V(6); PG8_BAR;
    for (;;) {
        const bool has_next = S.next(ui + 1, nxt);
        const char* nA = has_next ? nxt.A : cA; const char* nB = has_next ? nxt.B : cB;
        for (int t = 0; t < nt; t += 2) {
            const bool last = (t == nt - 2);
            const char* a1 = cA + (size_t)(t + 1) * kstep;
            const char* a2 = last ? nA : cA + (size_t)(t + 2) * kstep; const char* b2 = last ? nB : cB + (size_t)(t + 2) * kstep;
            const char* a3 = a2 + kstep; const char* b3 = b2 + kstep;
            PG8_LDB(B0, 0, 0); PG8_LDB(B1, 0, 1); PG8_SCHED; PG8_LDA(At, 0, 0); PG8_STAGE(PG8_SA(1, 1), a1 + hA, voffA);
            PG8_WAIT_V(8); PG8_WAIT_L(0); PG8_BAR; PG8_MMA(0, 0, At, B0); PG8_MMA(0, 1, At, B1); PG8_BAR; PG8_SCHED;
            PG8_LDA(At, 0, 1); PG8_STAGE(PG8_SB(0, 0), b2, voffB); PG8_STAGE(PG8_SB(0, 1), b2 + hB, voffB); PG8_STAGE(PG8_SA(0, 0), a2, voffA);
            PG8_WAIT_V(8); PG8_WAIT_L(0); PG8_BAR; PG8_MMA(1, 0, At, B0); PG8_MMA(1, 1, At, B1); PG8_BAR; PG8_SCHED;
            PG8_LDB(B0, 1, 0); PG8_LDB(B1, 1, 1); PG8_SCHED; PG8_LDA(At, 1, 0); PG8_STAGE(PG8_SA(0, 1), a2 + hA, voffA);
            PG8_WAIT_V(8); PG8_WAIT_L(0); PG8_BAR; PG8_MMA(0, 0, At, B0); PG8_MMA(0, 1, At, B1); PG8_BAR; PG8_SCHED;
            PG8_LDA(At, 1, 1); PG8_STAGE(PG8_SB(1, 0), b3, voffB); PG8_STAGE(PG8_SB(1, 1), b3 + hB, voffB); PG8_STAGE(PG8_SA(1, 0), a3, voffA);
            PG8_WAIT_V(8); PG8_WAIT_L(0); PG8_BAR; PG8_MMA(1, 0, At, B0); PG8_MMA(1, 1, At, B1); PG8_BAR; PG8_SCHED;
        }
        if constexpr (ALIGN_EPI) { if (wr == 0) PG8_BAR; }
        E(acc, cur, wr, wc, fr, fq);
        if (!has_next) break;
#pragma unroll
        for (int a = 0; a < 2; ++a)
#pragma unroll
            for (int b = 0; b < 2; ++b)
#pragma unroll
                for (int m = 0; m < 4; ++m)
#pragma unroll
                    for (int n = 0; n < 2; ++n) acc[a][b][m][n] = (f32x4){0.f, 0.f, 0.f, 0.f};
        cur = nxt; cA = nA; cB = nB; ++ui;
        if constexpr (ALIGN_EPI) { if (wr == 1) PG8_BAR; }
    }
    PG8_WAIT_V(0);
    if constexpr (!ALIGN_EPI) { if (wr == 0) PG8_BAR; }
    PG8_BAR;
#undef PG8_SA
#undef PG8_SB
#undef PG8_STAGE
#undef PG8_LDA
#undef PG8_LDB
#undef PG8_MMA
#undef PG8_WAIT_V
#undef PG8_WAIT_L
#undef PG8_BAR
#undef PG8_SCHED
}
}
namespace attn {
using pg8::bf16_t; using pg8::bf16x8; using pg8::u32x4;
typedef short s16x4 __attribute__((ext_vector_type(4)));
typedef float f32x16 __attribute__((ext_vector_type(16)));
constexpr float SCALE = 0.07216878364870322f;
constexpr float C2 = 1.4426950408889634f * SCALE;
constexpr float THR = 8.f;
constexpr int KVBLK = 64, SHM_V = 16384, SHM_KN = 16384, SHM_KR = 8192;
constexpr int OFF_V = 0, OFF_KN = 2 * SHM_V, OFF_KR = OFF_KN + 2 * SHM_KN, OFF_WS = OFF_KR + 2 * SHM_KR, LDS_BYTES = OFF_WS + 8 * 64 * 4;
#define KSWZ(row, colB) ((row) * 256 + ((colB) ^ (((row) & 7) << 4)))
#define SBAR() __builtin_amdgcn_sched_barrier(0)
__device__ __forceinline__ int v_st(int k, int c) { const int kk = (k & ~0xC) | ((k & 4) << 1) | ((k & 8) >> 1); return ((kk >> 3) * 4 + (c >> 5)) * 512 + ((kk & 7) * 32 + (c & 31)) * 2; }
__device__ __forceinline__ int v_rd_base(int lane) { return ((lane & 3) << 3) | (((lane >> 2) & 3) << 6) | (((lane >> 4) & 1) << 5) | (((lane >> 5) & 1) << 8); }
__device__ __forceinline__ int crow(int r, int hi) { return (r & 3) + 8 * (r >> 2) + 4 * hi; }
__device__ __forceinline__ unsigned cvtpk(float lo, float hi) { unsigned r; asm volatile("v_cvt_pk_bf16_f32 %0, %1, %2" : "=v"(r) : "v"(lo), "v"(hi)); return r; }

__device__ __forceinline__ void mask_tile(f32x16& p, int dq) {
    const float NEG = -__builtin_inff();
#pragma unroll
    for (int r = 0; r < 16; ++r) { const int c = (r & 3) + 8 * (r >> 2); if (dq - c < 0) p[r] = NEG; }
}
__device__ __forceinline__ void partialSM(f32x16& p, float& m_reg, float& alpha) {
    float pmax = p[0];
#pragma unroll
    for (int r = 1; r < 16; ++r) pmax = fmaxf(pmax, p[r]);
    { auto rr = __builtin_amdgcn_permlane32_swap(__float_as_uint(pmax), __float_as_uint(pmax), false, false); pmax = fmaxf(__uint_as_float(rr[0]), __uint_as_float(rr[1])); }
    float mn;
    if (__builtin_expect(__all((pmax - m_reg) * SCALE <= THR), 1)) { mn = m_reg; alpha = 1.f; }
    else { mn = fmaxf(m_reg, pmax); alpha = __builtin_amdgcn_exp2f((m_reg - mn) * C2); m_reg = mn; }
    const float mnL = -mn * C2;
#pragma unroll
    for (int r = 0; r < 16; ++r) p[r] = __builtin_amdgcn_exp2f(fmaf(p[r], C2, mnL));
}
__device__ __forceinline__ void finishSM(const f32x16& p, float alpha, float& l_reg, bf16x8& pa0, bf16x8& pa1) {
    float ps = 0.f;
#pragma unroll
    for (int r = 0; r < 16; ++r) ps += p[r];
    { auto rr = __builtin_amdgcn_permlane32_swap(__float_as_uint(ps), __float_as_uint(ps), false, false); ps = __uint_as_float(rr[0]) + __uint_as_float(rr[1]); }
    l_reg = l_reg * alpha + ps;
#define PK4(P, B_, OUT) do { unsigned a0 = cvtpk(P[B_+0], P[B_+1]), a1 = cvtpk(P[B_+2], P[B_+3]); unsigned b0 = cvtpk(P[B_+4], P[B_+5]), b1 = cvtpk(P[B_+6], P[B_+7]); \
        auto r0 = __builtin_amdgcn_permlane32_swap(a0, b0, false, false); auto r1 = __builtin_amdgcn_permlane32_swap(a1, b1, false, false); \
        u32x4 w = {r0[0], r1[0], r0[1], r1[1]}; OUT = *reinterpret_cast<bf16x8*>(&w); } while (0)
    PK4(p, 0, pa0); PK4(p, 8, pa1);
#undef PK4
}
template <int KB>
__device__ __forceinline__ void qkt(f32x16& p, const char* KN_lds, const char* KR_lds, int par, int r32, int hi, const bf16x8* qr) {
    p = f32x16{};
    const char* kb[4];
#pragma unroll
    for (int dd = 0; dd < 4; ++dd) kb[dd] = KN_lds + KB * SHM_KN + par * (32 * 256) + KSWZ(r32, (dd * 16 + hi * 8) * 2);
#pragma unroll
    for (int d0 = 0; d0 < 8; ++d0) { const bf16x8 a = *reinterpret_cast<const bf16x8*>(kb[d0 & 3] + (d0 >> 2) * 128); p = __builtin_amdgcn_mfma_f32_32x32x16_bf16(a, qr[d0], p, 0, 0, 0); }
    const char* rb = KR_lds + KB * SHM_KR + hi * 1024 + (par * 32 + r32) * 16;
#pragma unroll
    for (int d0 = 0; d0 < 4; ++d0) { const bf16x8 a = *reinterpret_cast<const bf16x8*>(rb + d0 * 2048); p = __builtin_amdgcn_mfma_f32_32x32x16_bf16(a, qr[8 + d0], p, 0, 0, 0); }
}
template <int VB>
__device__ __forceinline__ void pv_tile(f32x16* o, int vbp, bf16x8 pa0, bf16x8 pa1) {
#define TRRD(dst, off) asm volatile("ds_read_b64_tr_b16 %0, %1 offset:%2" : "=&v"(dst) : "v"(vbp), "i"(off) : "memory")
#define PV_D0(d0) do { s16x4 l0, l1, h0, h1; constexpr int b_ = VB * SHM_V + (d0) * 512; \
        TRRD(l0, b_); TRRD(h0, b_ + 2048); TRRD(l1, b_ + 4096); TRRD(h1, b_ + 6144); \
        asm volatile("s_waitcnt lgkmcnt(0)" ::: "memory"); SBAR(); \
        o[d0] = __builtin_amdgcn_mfma_f32_32x32x16_bf16(pa0, (bf16x8){l0[0], l0[1], l0[2], l0[3], h0[0], h0[1], h0[2], h0[3]}, o[d0], 0, 0, 0); \
        o[d0] = __builtin_amdgcn_mfma_f32_32x32x16_bf16(pa1, (bf16x8){l1[0], l1[1], l1[2], l1[3], h1[0], h1[1], h1[2], h1[3]}, o[d0], 0, 0, 0); } while (0)
    PV_D0(0); PV_D0(1); PV_D0(2); PV_D0(3);
#undef PV_D0
#undef TRRD
}

__device__ __forceinline__ void attn_block(int b, int h, int qb, const bf16_t* __restrict__ Qb, const bf16_t* __restrict__ KVb, const bf16_t* __restrict__ KRb, bf16_t* __restrict__ CAT, char* lds) {
    const int tid = pg8::launder((int)threadIdx.x), wid = __builtin_amdgcn_readfirstlane(tid >> 6), lane = tid & 63, r32 = lane & 31, hi = lane >> 5;
    const int rg = wid & 3, par = wid >> 2;
    const size_t rowbase = (size_t)b * S; const int q0 = qb * 128, NT = 2 * (qb + 1);
    char* V_lds = lds + OFF_V; char* KN_lds = lds + OFF_KN; char* KR_lds = lds + OFF_KR;
    float* ws = (float*)(lds + OFF_WS) + wid * 64; float* li_l = ws; float* al_l = ws + 32;
    const int sr = tid >> 4, sc = (tid & 15) * 8, vst0 = v_st(sr, sc), vst1 = v_st(32 + sr, sc), kws = KSWZ(sr, sc * 2);
    const int krow = tid & 63, kch = tid >> 6, krs = kch * 1024 + krow * 16;
    const char* kvu = (const char*)(KVb + rowbase * KVW + h * 256); const char* ru = (const char*)(KRb + rowbase * 64);
    const unsigned lo_kv = (unsigned)(sr * KVW + sc) * 2u, lo_r = (unsigned)(krow * 64 + kch * 8) * 2u;
    const int vbp = (int)(uintptr_t)V_lds + v_rd_base(lane) + par * 8192;
    bf16x8 st_k0, st_k1, st_v0, st_v1, st_r;
#define SLOAD(k0) do { const char* kb_ = kvu + (size_t)(k0) * (KVW * 2); \
        st_v0 = *(const bf16x8*)(kb_ + 256 + (size_t)lo_kv); st_v1 = *(const bf16x8*)(kb_ + 256 + 32 * KVW * 2 + (size_t)lo_kv); \
        st_k0 = *(const bf16x8*)(kb_ + (size_t)lo_kv); st_k1 = *(const bf16x8*)(kb_ + 32 * KVW * 2 + (size_t)lo_kv); st_r = *(const bf16x8*)(ru + (size_t)(k0) * 128 + (size_t)lo_r); } while (0)
#define SWRITE(bf) do { *(bf16x8*)(V_lds + (bf) * SHM_V + vst0) = st_v0; *(bf16x8*)(V_lds + (bf) * SHM_V + vst1) = st_v1; \
        *(bf16x8*)(KN_lds + (bf) * SHM_KN + kws) = st_k0; *(bf16x8*)(KN_lds + (bf) * SHM_KN + kws + 32 * 256) = st_k1; *(bf16x8*)(KR_lds + (bf) * SHM_KR + krs) = st_r; } while (0)
#define VMW() asm volatile("s_waitcnt vmcnt(0)" ::: "memory")
    SLOAD(0);
    bf16x8 qr[12];
    { const char* qu = (const char*)(Qb + (rowbase + q0 + rg * 32) * QW + h * 192); const unsigned lo_q = (unsigned)(r32 * QW + hi * 8) * 2u;
#pragma unroll
      for (int d0 = 0; d0 < 12; ++d0) qr[d0] = *(const bf16x8*)(qu + d0 * 32 + (size_t)lo_q); }
    float m_reg = -1e30f, l_reg = 0.f; f32x16 o[4] = {};
    const int qrel = q0 + rg * 32;
    const int dq0 = qrel + r32 - 32 * par - 4 * hi;
#define MASKT(P, t) do { const int kb_ = 64 * (t) + 32 * par; if (kb_ + 31 > qrel) mask_tile(P, dq0 - 64 * (t)); } while (0)
#define RESC(a) do { if (__any((a) < 1.f)) { if (hi == 0) al_l[r32] = (a); asm volatile("s_waitcnt lgkmcnt(0)" ::: "memory"); \
        _Pragma("unroll") for (int d_ = 0; d_ < 4; ++d_) _Pragma("unroll") for (int r = 0; r < 16; ++r) o[d_][r] *= al_l[crow(r, hi)]; } } while (0)
    f32x16 pA, pB; float alA, alB; bf16x8 pa0, pa1;
    VMW(); SWRITE(0);
    __syncthreads();
    SLOAD(64);
    SBAR(); qkt<0>(pA, KN_lds, KR_lds, par, r32, hi, qr);
    MASKT(pA, 0); partialSM(pA, m_reg, alA);
    VMW(); SWRITE(1);
    __syncthreads();
#define HALF_STEP(PX, alX, PY, alY, t, KB, VB, SB) do { \
        SBAR(); qkt<KB>(PX, KN_lds, KR_lds, par, r32, hi, qr); \
        finishSM(PY, alY, l_reg, pa0, pa1); SBAR(); \
        if ((t) + 1 < NT) { SLOAD(((t) + 1) * 64); SBAR(); } \
        pv_tile<VB>(o, vbp, pa0, pa1); MASKT(PX, (t)); partialSM(PX, m_reg, alX); \
        __syncthreads(); \
        if ((t) + 1 < NT) { VMW(); SWRITE(SB); } \
        RESC(alX); __syncthreads(); } while (0)
    for (int t = 1; t + 1 < NT; t += 2) {
        HALF_STEP(pB, alB, pA, alA, t, 1, 0, 0);
        HALF_STEP(pA, alA, pB, alB, t + 1, 0, 1, 1);
    }
    SBAR(); qkt<1>(pB, KN_lds, KR_lds, par, r32, hi, qr); SBAR();
    finishSM(pA, alA, l_reg, pa0, pa1); SBAR();
    pv_tile<0>(o, vbp, pa0, pa1);
    MASKT(pB, NT - 1); partialSM(pB, m_reg, alB); RESC(alB);
    finishSM(pB, alB, l_reg, pa0, pa1); SBAR(); pv_tile<1>(o, vbp, pa0, pa1);
    __syncthreads();
    float* mo = (float*)lds; float* ml = (float*)(lds + 65536);
    if (par == 1) {
#pragma unroll
        for (int d0 = 0; d0 < 4; ++d0)
#pragma unroll
            for (int r = 0; r < 16; ++r) mo[(rg * 64 + d0 * 16 + r) * 64 + lane] = o[d0][r];
        if (hi == 0) { ml[rg * 64 + r32] = m_reg; ml[rg * 64 + 32 + r32] = l_reg; }
    }
    __syncthreads();
    if (par == 0) {
        const float m1 = ml[rg * 64 + r32], l1 = ml[rg * 64 + 32 + r32];
        const float m = fmaxf(m_reg, m1), a0 = __builtin_amdgcn_exp2f((m_reg - m) * C2), a1 = __builtin_amdgcn_exp2f((m1 - m) * C2);
        const float linv = 1.f / (l_reg * a0 + l1 * a1);
        if (hi == 0) { li_l[r32] = a0 * linv; al_l[r32] = a1 * linv; }
        asm volatile("s_waitcnt lgkmcnt(0)" ::: "memory");
        char* ou = (char*)(CAT + (rowbase + q0 + rg * 32) * 2048 + h * 128); const unsigned lo_o = (unsigned)(4 * hi * 2048 + r32) * 2u;
#pragma unroll
        for (int r = 0; r < 16; ++r) { const int orow = crow(r, hi); const float f0 = li_l[orow], f1 = al_l[orow];
#pragma unroll
            for (int d0 = 0; d0 < 4; ++d0) { const float v = o[d0][r] * f0 + mo[(rg * 64 + d0 * 16 + r) * 64 + lane] * f1; const float vn = __shfl_xor(v, 1);
                if ((r32 & 1) == 0) *(unsigned*)(ou + (((r & 3) + 8 * (r >> 2)) * 4096 + d0 * 64) + (size_t)lo_o) = cvtpk(v, vn); }
            asm volatile("" ::: "memory"); }
    }
    __syncthreads();
#undef SLOAD
#undef SWRITE
#undef VMW
#undef MASKT
#undef RESC
#undef HALF_STEP
}
#undef KSWZ
#undef SBAR
}

namespace sgu {
using pg8::bf16_t; using pg8::bf16x8; using pg8::f32x4; using pg8::u32x4; using pg8::u32x2;
constexpr int VT_PITCH = 272;
constexpr int LDS_BYTES = 128 * VT_PITCH;
__device__ __forceinline__ float bf2f(unsigned short v) { return __uint_as_float((unsigned)v << 16); }
__device__ __forceinline__ void sgu_unit(int n, int g, const bf16_t* __restrict__ ZU, const bf16_t* __restrict__ ZV, const float* __restrict__ ng, const float* __restrict__ nb,
                                         const float* __restrict__ W, const float* __restrict__ bs, bf16_t* __restrict__ CAT, char* lds) {
    const int tid = pg8::launder((int)threadIdx.x), wid = __builtin_amdgcn_readfirstlane(tid >> 6), lane = tid & 63, fr = lane & 15, fq = lane >> 4;
    const size_t t0 = (size_t)n * CH;
    {
        const int row = tid >> 2, q = tid & 3; const char* src = (const char*)(ZV + t0 * SGW + g * GD) + (size_t)((unsigned)(row * SGW + q * 32) * 2u);
        float v[32];
#pragma unroll
        for (int i = 0; i < 4; ++i) { const u32x4 w = *(const u32x4*)(src + 16 * i);
#pragma unroll
            for (int e = 0; e < 4; ++e) { v[8 * i + 2 * e] = __uint_as_float(w[e] << 16); v[8 * i + 2 * e + 1] = __uint_as_float(w[e] & 0xffff0000u); } }
        float s = 0.f;
#pragma unroll
        for (int i = 0; i < 32; ++i) s += v[i];
        s += __shfl_xor(s, 1); s += __shfl_xor(s, 2);
        const float mu = s * (1.f / GD); float qq = 0.f;
#pragma unroll
        for (int i = 0; i < 32; ++i) { v[i] -= mu; qq += v[i] * v[i]; }
        qq += __shfl_xor(qq, 1); qq += __shfl_xor(qq, 2);
        const float rstd = 1.f / sqrtf(qq * (1.f / GD) + LN_EPS);
        const float* gp = (const float*)((const char*)(ng + g * GD) + (size_t)((unsigned)q * 128u)); const float* bp = (const float*)((const char*)(nb + g * GD) + (size_t)((unsigned)q * 128u));
#pragma unroll
        for (int i4 = 0; i4 < 32; i4 += 4) { const f32x4 g4 = *(const f32x4*)(gp + i4), b4 = *(const f32x4*)(bp + i4);
#pragma unroll
            for (int e = 0; e < 4; e += 2) { const int i = i4 + e; const unsigned pk = pg8::cvt_pk_bf16(v[i] * rstd * g4[e] + b4[e], v[i + 1] * rstd * g4[e + 1] + b4[e + 1]);
                *(unsigned short*)(lds + (q * 32 + i) * VT_PITCH + row * 2) = (unsigned short)(pk & 0xffffu); *(unsigned short*)(lds + (q * 32 + i + 1) * VT_PITCH + row * 2) = (unsigned short)(pk >> 16); }
            asm volatile("" ::: "memory"); }
    }
    __syncthreads();
    f32x4 acc[8];
#pragma unroll
    for (int cb = 0; cb < 8; ++cb) acc[cb] = (f32x4){0.f, 0.f, 0.f, 0.f};
    const int tl = wid * 16 + fr;
    const float* wrow = (const float*)((const char*)(W + (size_t)g * CH * CH) + (size_t)((unsigned)(tl * CH) * 4u));
#pragma unroll
    for (int ks = 0; ks < 4; ++ks) {
        if (ks * 32 <= wid * 16 + 15) {
            const int s0 = ks * 32 + 8 * fq; const f32x4 w0 = *(const f32x4*)(wrow + s0), w1 = *(const f32x4*)(wrow + s0 + 4);
            float wv[8] = {w0[0], w0[1], w0[2], w0[3], w1[0], w1[1], w1[2], w1[3]};
#pragma unroll
            for (int e = 0; e < 8; ++e) wv[e] = (s0 + e <= tl) ? wv[e] : 0.f;
            u32x4 wp; wp.x = pg8::cvt_pk_bf16(wv[0], wv[1]); wp.y = pg8::cvt_pk_bf16(wv[2], wv[3]); wp.z = pg8::cvt_pk_bf16(wv[4], wv[5]); wp.w = pg8::cvt_pk_bf16(wv[6], wv[7]);
            const bf16x8 bfrag = *reinterpret_cast<const bf16x8*>(&wp);
#pragma unroll
            for (int cb = 0; cb < 8; ++cb) { const bf16x8 afrag = *(const bf16x8*)(lds + (cb * 16 + fr) * VT_PITCH + s0 * 2);
                acc[cb] = __builtin_amdgcn_mfma_f32_16x16x32_bf16(afrag, bfrag, acc[cb], 0, 0, 0); }
        }
        asm volatile("" ::: "memory");
    }
    const float bias = bs[g * CH + tl];
    const bf16_t* up = (const bf16_t*)((const char*)(ZU + t0 * SGW + g * GD) + (size_t)((unsigned)(tl * SGW + 4 * fq) * 2u)); bf16_t* op = (bf16_t*)((char*)(CAT + t0 * 2048 + 1024 + g * GD) + (size_t)((unsigned)(tl * 2048 + 4 * fq) * 2u));
#pragma unroll
    for (int cb = 0; cb < 8; ++cb) { const u32x2 uw = *(const u32x2*)(up + cb * 16);
        const float u0 = __uint_as_float(uw.x << 16), u1 = __uint_as_float(uw.x & 0xffff0000u), u2 = __uint_as_float(uw.y << 16), u3 = __uint_as_float(uw.y & 0xffff0000u);
        u32x2 ow; ow.x = pg8::cvt_pk_bf16(u0 * (acc[cb][0] + bias), u1 * (acc[cb][1] + bias)); ow.y = pg8::cvt_pk_bf16(u2 * (acc[cb][2] + bias), u3 * (acc[cb][3] + bias));
        *(u32x2*)(op + cb * 16) = ow; if (cb & 1) asm volatile("" ::: "memory"); }
    __syncthreads();
}
}
#define GAS __attribute__((address_space(1)))
#define LAS __attribute__((address_space(3)))
typedef unsigned short bf16;
typedef unsigned v4u __attribute__((ext_vector_type(4)));
typedef unsigned v2u __attribute__((ext_vector_type(2)));
typedef float f32x4 __attribute__((ext_vector_type(4)));
typedef GAS unsigned gu32;
#define RLX_AGENT __ATOMIC_RELAXED, __HIP_MEMORY_SCOPE_AGENT
#define LDS_WAIT() asm volatile("s_waitcnt lgkmcnt(0)" ::: "memory")
#define VM_WAIT() asm volatile("s_waitcnt vmcnt(0)" ::: "memory")

constexpr int NWAVES = 8;
constexpr size_t MiB = 1u << 20;
constexpr size_t WS_CTL = 0, CTL_ZERO_BYTES = 1 * MiB;
constexpr size_t WS_MOD = 1 * MiB, WS_COS = 2 * MiB, WS_SIN = 3 * MiB, WS_SSQQ = 4 * MiB, WS_SSQKV = 5 * MiB, WS_KRAW = 6 * MiB, WS_KRB = 8 * MiB, WS_ROWTS = 9 * MiB, WS_ROWW = 10 * MiB;
constexpr size_t WS_X = 16 * MiB, WS_VB = 80 * MiB, WS_HMB = 144 * MiB, WS_W = 176 * MiB, WS_ACT = 464 * MiB, WS_END = 1264 * MiB;
constexpr size_t WS_CQ = WS_ACT, WS_CKV = WS_CQ + 12 * MiB, WS_ZU = WS_CKV + 8 * MiB, WS_ZV = WS_ZU + 16 * MiB, WS_QB = WS_ZV + 16 * MiB, WS_KVB = WS_QB + 24 * MiB, WS_CAT = WS_KVB + 32 * MiB, WS_H = WS_CAT + 32 * MiB;
static_assert(WS_H + (size_t)T * FF * 2 <= WS_END, "even map");
constexpr size_t WS_PD = WS_ACT, WS_PP = WS_PD + 32 * MiB, WS_HMS = WS_PP + 32 * MiB, WS_HS = WS_HMS + (size_t)NE * CAP * D * 2, WS_YS = WS_HS + (size_t)NE * CAP * FE * 2;
static_assert(WS_YS + (size_t)2 * T * D * 4 <= WS_END, "odd map");
constexpr size_t WE_IN = 0, WE_Q = WE_IN + (size_t)INWP * D, WE_KV = WE_Q + (size_t)QW * QL, WE_OUT = WE_KV + (size_t)KVW * KVL, WE_GU = WE_OUT + (size_t)D * D, WE_DN = WE_GU + (size_t)2 * FF * D, WE_END = WE_DN + (size_t)D * FF;
constexpr size_t WO_POOL = 0, WO_OC = WO_POOL + (size_t)D * 512, WO_GU = WO_OC + (size_t)D * D, WO_DN = WO_GU + (size_t)NE * 2 * FE * D, WO_END = WO_DN + (size_t)NE * D * FE;
static_assert(WE_END * 2 <= 288 * MiB && WO_END * 2 <= 288 * MiB, "weight region");
constexpr int CW_BAR = 4096;
constexpr int CW_MOECNT = 16384;
constexpr int RING_BYTES = 131072, LDSCTL_OFF = RING_BYTES, MISC_OFF = LDSCTL_OFF + 320, LDS_BYTES = 147456;

__device__ __forceinline__ unsigned pk2(float lo, float hi) { return pg8::cvt_pk_bf16(lo, hi); }

#define XB_TMO      128
#define XB_XCNT(j)  (256  + 64 * (j))
#define XB_XSUB(j)  (1280 + 64 * (j))
#define XB_XGEN(j)  (2304 + 64 * (j))
#define XB_TOP      3328
#define XB_TOPGEN   3392
#define XCD_BAR_WORDS 3456
#define XB_SPIN_CAP (1u << 18)
__device__ __forceinline__ unsigned xb_ld(unsigned* p)              { return __hip_atomic_load(p, __ATOMIC_RELAXED, __HIP_MEMORY_SCOPE_AGENT); }
__device__ __forceinline__ unsigned xb_add(unsigned* p, unsigned v) { return __hip_atomic_fetch_add(p, v, __ATOMIC_RELAXED, __HIP_MEMORY_SCOPE_AGENT); }
__device__ __forceinline__ unsigned xb_xcc_id() { return (unsigned)__builtin_amdgcn_s_getreg((3 << 11) | 20) & 0xFu; }
#define XB_SPIN(cond, bar) do { unsigned _sp = 0; while (cond) { __builtin_amdgcn_s_sleep(1); \
    if ((++_sp & 255u) == 0u) { if (xb_ld(&(bar)[XB_TMO])) break; if (_sp > XB_SPIN_CAP) { atomicAdd(&(bar)[XB_TMO], 1u); break; } } } } while (0)
struct XcdBarrier { unsigned* bar; unsigned x; volatile LAS unsigned* st; };
__device__ __forceinline__ XcdBarrier xcd_barrier_post(unsigned* bar, volatile LAS unsigned* st) {
    XcdBarrier b; b.bar = bar; b.x = xb_xcc_id(); b.st = st;
    if (threadIdx.x == 0) (void)xb_add(&bar[XB_XCNT(b.x)], 1u);
    return b;
}
__device__ __forceinline__ void xcd_barrier_complete(unsigned* bar, unsigned x, unsigned& nloc, unsigned& nx) {
    const unsigned G = gridDim.x * gridDim.y * gridDim.z;
    unsigned sum, cnt, mine, sp = 0u;
    for (;;) {
        sum = 0u; cnt = 0u; mine = 0u;
#pragma unroll
        for (unsigned j = 0; j < 16; ++j) { const unsigned c = xb_ld(&bar[XB_XCNT(j)]); sum += c; cnt += (c > 0u) ? 1u : 0u; mine = (j == x) ? c : mine; }
        if (sum == G) break;
        __builtin_amdgcn_s_sleep(1);
        if ((++sp & 255u) == 0u) { if (xb_ld(&bar[XB_TMO])) break; if (sp > XB_SPIN_CAP) { atomicAdd(&bar[XB_TMO], 1u); break; } }
    }
    nloc = mine > 0u ? mine : 1u; nx = cnt > 0u ? cnt : 1u;
}
__device__ __forceinline__ void xcd_barrier(const XcdBarrier& b) {
    asm volatile("s_waitcnt vmcnt(0)" ::: "memory");
    __syncthreads();
    if (threadIdx.x == 0) {
        unsigned* bar = b.bar;
        __builtin_amdgcn_s_waitcnt(0);
        unsigned nloc = b.st[0], nx = b.st[1];
        if (nloc == 0u) { xcd_barrier_complete(bar, b.x, nloc, nx); b.st[0] = nloc; b.st[1] = nx; }
        const unsigned old = xb_add(&bar[XB_XSUB(b.x)], 1u);
        const unsigned gen = old / nloc;
        if (old + 1u == (gen + 1u) * nloc) {
            __builtin_amdgcn_fence(__ATOMIC_RELEASE, "agent");
            asm volatile("s_waitcnt vmcnt(0)" ::: "memory");
            const unsigned og = xb_add(&bar[XB_TOP], 1u);
            const unsigned tg = og / nx;
            if (og + 1u == (tg + 1u) * nx) xb_add(&bar[XB_TOPGEN], 1u);
            else XB_SPIN(xb_ld(&bar[XB_TOPGEN]) == tg, bar);
            __builtin_amdgcn_fence(__ATOMIC_ACQUIRE, "agent");
            xb_add(&bar[XB_XGEN(b.x)], 1u);
            asm volatile("s_waitcnt vmcnt(0)" ::: "memory");
        } else {
            XB_SPIN(xb_ld(&bar[XB_XGEN(b.x)]) == gen, bar);
            __builtin_amdgcn_fence(__ATOMIC_ACQUIRE, "agent");
            asm volatile("s_waitcnt vmcnt(0)" ::: "memory");
        }
    }
    __syncthreads();
}

struct Frame {
    LAS unsigned char* lds; volatile LAS unsigned* MISC; gu32* ctl; unsigned char* ws;
    int tid, lane, wave, vcu, G, gw, NGW;
    const float* const* in; float* out;
};
__device__ __forceinline__ float wave_sum(float v) {
#pragma unroll
    for (int o = 1; o < 64; o <<= 1) v += __shfl_xor(v, o);
    return v;
}
__device__ __forceinline__ void conv_item(const float* W, int N, bf16* WT, int ldk, int dst_row0, const float* kscale, LAS float* scr, int k0, int n0, int lane) {
#pragma unroll 8
    for (int i = 0; i < 32; ++i) { const int kk = 2 * i + (lane >> 5); float v = W[(size_t)(k0 + kk) * N + n0 + (lane & 31)]; if (kscale) v *= kscale[k0 + kk]; scr[kk * 33 + (lane & 31)] = v; }
    LDS_WAIT(); asm volatile("" ::: "memory");
    const int c = lane & 7;
#pragma unroll
    for (int j = 0; j < 4; ++j) { const int n = (lane >> 3) + 8 * j; const LAS float* s = scr + (8 * c) * 33 + n;
        v4u o; o.x = pk2(s[0 * 33], s[1 * 33]); o.y = pk2(s[2 * 33], s[3 * 33]); o.z = pk2(s[4 * 33], s[5 * 33]); o.w = pk2(s[6 * 33], s[7 * 33]);
        *(GAS v4u*)(WT + (size_t)(dst_row0 + n) * ldk + k0 + 8 * c) = o; }
    LDS_WAIT(); asm volatile("" ::: "memory");
}
template <class RowMap>
__device__ __forceinline__ bool conv_mat(int& it, const float* W, int K, int N, bf16* WT, const float* kscale, LAS float* scr, int lane, RowMap rm) {
    const int nblk = N / 32, cnt = (K / 64) * nblk; if (it >= cnt) { it -= cnt; return false; }
    const int kb = it / nblk, nb = it % nblk; conv_item(W, N, WT, K, rm(nb * 32), kscale, scr, kb * 64, nb * 32, lane); return true;
}
struct RmId { int off; __device__ int operator()(int n0) const { return off + n0; } };
struct RmIn { __device__ int operator()(int n0) const { return n0 < 1280 ? n0 : (n0 < 1344 ? 3328 + (n0 - 1280) : n0 - 64); } };
struct RmQ { __device__ int operator()(int n0) const { const int head = n0 / 192, w = n0 % 192; return w < 128 ? (head >> 1) * 256 + (head & 1) * 128 + w : 1024 + (head >> 2) * 256 + ((w - 128) >> 5) * 128 + (head & 3) * 32; } };
struct RmGU { int up; __device__ int operator()(int n0) const { return (n0 >> 7) * 256 + up * 128 + (n0 & 127); } };

__device__ __forceinline__ void convert_even(Frame& F, int j) {
    const int ln_ = pg8::launder(F.lane);
    LAS float* scr = (LAS float*)(F.lds + F.wave * 16384); bf16* Wb = (bf16*)(F.ws + WS_W);
    constexpr int NIT = (D / 64) * (INW / 32) + (QL / 64) * (QW / 32) + (KVL / 64) * (KVW / 32) + (D / 64) * (D / 32) + 2 * (D / 64) * (FF / 32) + (FF / 64) * (D / 32);
    for (int it0 = F.gw; it0 < NIT; it0 += F.NGW) { int it = it0;
        if (conv_mat(it, F.in[7] + (size_t)j * D * INW, D, INW, Wb + WE_IN, nullptr, scr, ln_, RmIn{})) continue;
        if (conv_mat(it, F.in[9] + (size_t)j * QL * QW, QL, QW, Wb + WE_Q, F.in[8] + j * QL, scr, ln_, RmQ{})) continue;
        if (conv_mat(it, F.in[11] + (size_t)j * KVL * KVW, KVL, KVW, Wb + WE_KV, F.in[10] + j * KVL, scr, ln_, RmId{0})) continue;
        if (conv_mat(it, F.in[16] + (size_t)j * D * D, D, D, Wb + WE_OUT, nullptr, scr, ln_, RmId{0})) continue;
        if (conv_mat(it, F.in[17] + (size_t)j * D * FF, D, FF, Wb + WE_GU, nullptr, scr, ln_, RmGU{0})) continue;
        if (conv_mat(it, F.in[18] + (size_t)j * D * FF, D, FF, Wb + WE_GU, nullptr, scr, ln_, RmGU{1})) continue;
        conv_mat(it, F.in[19] + (size_t)j * FF * D, FF, D, Wb + WE_DN, nullptr, scr, ln_, RmId{0});
    }
}
__device__ __forceinline__ void convert_odd(Frame& F, int j) {
    const int ln_ = pg8::launder(F.lane);
    LAS float* scr = (LAS float*)(F.lds + F.wave * 16384); bf16* Wb = (bf16*)(F.ws + WS_W);
    constexpr int NPOOL = (512 / 64) * (512 / 32), NOC = (D / 64) * (D / 32), NGU = (D / 64) * (FE / 32), NDN = (FE / 64) * (D / 32), NEXP = 2 * NGU + NDN;
    constexpr int NIT = 4 * NPOOL + NOC + NE * NEXP;
    for (int it0 = F.gw; it0 < NIT; it0 += F.NGW) { int it = it0;
        if (it < 4 * NPOOL) { const int gi = it / NPOOL; it -= gi * NPOOL; conv_mat(it, F.in[20] + ((size_t)j * 4 + gi) * 512 * 512, 512, 512, Wb + WO_POOL, nullptr, scr, ln_, RmId{gi * 512}); continue; }
        it -= 4 * NPOOL;
        if (conv_mat(it, F.in[22] + (size_t)j * D * D, D, D, Wb + WO_OC, nullptr, scr, ln_, RmId{0})) continue;
        const int e = it / NEXP; it -= e * NEXP; const size_t eo = (size_t)j * NE + e;
        if (conv_mat(it, F.in[24] + eo * D * FE, D, FE, Wb + WO_GU + (size_t)e * 2 * FE * D, nullptr, scr, ln_, RmGU{0})) continue;
        if (conv_mat(it, F.in[25] + eo * D * FE, D, FE, Wb + WO_GU + (size_t)e * 2 * FE * D, nullptr, scr, ln_, RmGU{1})) continue;
        conv_mat(it, F.in[26] + eo * FE * D, FE, D, Wb + WO_DN + (size_t)e * D * FE, nullptr, scr, ln_, RmId{0});
    }
}
__device__ __forceinline__ void ada_phase(Frame& F) {
    const int ln_ = pg8::launder(F.lane);
    const float* c = F.in[1]; const float* aw = F.in[3]; const float* ab = F.in[4]; float* MOD = (float*)(F.ws + WS_MOD);
    LAS float* red = (LAS float*)(F.lds);
    for (int u = F.vcu; u < 8 * 96; u += F.G) {
        const int ls = u / 96, n = (u % 96) * 64 + ln_; const float* wp = aw + ((size_t)ls * D + F.wave * 256) * 3 * D + n;
        float a0 = 0.f, a1 = 0.f;
#pragma unroll 16
        for (int k = 0; k < 256; ++k) { const float wv = wp[(size_t)k * 3 * D]; const float c0 = c[F.wave * 256 + k], c1 = c[D + F.wave * 256 + k];
            a0 += pg8::silu_f(c0) * wv; a1 += pg8::silu_f(c1) * wv; }
        red[(F.wave * 2 + 0) * 64 + ln_] = a0; red[(F.wave * 2 + 1) * 64 + ln_] = a1;
        __syncthreads();
        if (F.wave < 2) { float s = 0.f;
#pragma unroll
            for (int w = 0; w < 8; ++w) s += red[(w * 2 + F.wave) * 64 + ln_];
            MOD[((size_t)ls * 2 + F.wave) * 3 * D + n] = s + ab[(size_t)ls * 3 * D + n]; }
        __syncthreads();
    }
}
__device__ const double ROPE_INV[32] = {1.0, 0.7498942093324559, 0.5623413251903491, 0.4216965034285822, 0.31622776601683794, 0.23713737056616552, 0.1778279410038923, 0.1333521432163324, 0.1, 0.07498942093324558, 0.05623413251903491, 0.042169650342858224, 0.03162277660168379, 0.023713737056616554, 0.01778279410038923, 0.01333521432163324, 0.01, 0.007498942093324558, 0.005623413251903491, 0.004216965034285823, 0.0031622776601683794, 0.0023713737056616554, 0.0017782794100389228, 0.001333521432163324, 0.001, 0.0007498942093324559, 0.0005623413251903491, 0.00042169650342858224, 0.00031622776601683794, 0.00023713737056616554, 0.00017782794100389227, 0.0001333521432163324};
__device__ __forceinline__ void rope_tab_phase(Frame& F) {
    const int* pos = (const int*)F.in[2]; float* cs = (float*)(F.ws + WS_COS); float* sn = (float*)(F.ws + WS_SIN);
    for (int i = F.vcu * 512 + pg8::launder(F.tid); i < T * 32; i += F.G * 512) {
        const int t = i >> 5, f = i & 31;
        const double ang = (double)pos[t] * ROPE_INV[f];
        const double kq = __builtin_rint(ang * 0.6366197723675814); const double r = ang - kq * 1.5707963267948966; const double r2 = r * r;
        const double sr = r * (1.0 + r2 * (-1.0 / 6 + r2 * (1.0 / 120 + r2 * (-1.0 / 5040 + r2 * (1.0 / 362880 + r2 * (-1.0 / 39916800 + r2 * (1.0 / 6227020800.0)))))));
        const double cr = 1.0 + r2 * (-0.5 + r2 * (1.0 / 24 + r2 * (-1.0 / 720 + r2 * (1.0 / 40320 + r2 * (-1.0 / 3628800 + r2 * (1.0 / 479001600.0))))));
        const int q = ((int)kq) & 3;
        const double s = (q == 0) ? sr : (q == 1) ? cr : (q == 2) ? -sr : -cr;
        const double cc = (q == 0) ? cr : (q == 1) ? -sr : (q == 2) ? -cr : sr;
        cs[i] = (float)cc; sn[i] = (float)s;
    }
}
template <int MODE, int NEXT>
__device__ __forceinline__ void ln_phase(Frame& F, const float* vsrc, const float* xres, const float* modcur, const float* ys, const float* lg, const float* lb, float* xout,
                                         const float* modnext, bf16* hmb, const float* rw, gu32* cnt, const bool do_hm) {
    const int ln_ = pg8::launder(F.lane);
    for (int row = F.gw; row < T; row += F.NGW) {
        const int b = row / S; f32x4 v[8];
        if (MODE == 0) {
#pragma unroll
            for (int j = 0; j < 8; ++j) v[j] = *(const GAS f32x4*)(vsrc + (size_t)row * D + 256 * j + 4 * ln_);
        } else {
            const float* gate = modcur + (size_t)b * 3 * D + 2 * D;
#pragma unroll
            for (int j = 0; j < 8; ++j) { const int col = 256 * j + 4 * ln_; const f32x4 x = *(const GAS f32x4*)(xres + (size_t)row * D + col), y0 = *(const GAS f32x4*)(ys + (size_t)(2 * row) * D + col),
                y1 = *(const GAS f32x4*)(ys + (size_t)(2 * row + 1) * D + col), g = *(const GAS f32x4*)(gate + col); v[j] = x * ALPHA + (g + 1.f) * (y0 + y1); }
        }
        float s = 0.f;
#pragma unroll
        for (int j = 0; j < 8; ++j) s += (v[j][0] + v[j][1]) + (v[j][2] + v[j][3]);
        const float mean = wave_sum(s) * (1.f / D); float s2 = 0.f;
#pragma unroll
        for (int j = 0; j < 8; ++j) { v[j] = v[j] - mean; s2 += (v[j][0] * v[j][0] + v[j][1] * v[j][1]) + (v[j][2] * v[j][2] + v[j][3] * v[j][3]); }
        const float rstd = 1.f / sqrtf(wave_sum(s2) * (1.f / D) + LN_EPS);
#pragma unroll
        for (int j = 0; j < 8; ++j) { const int col = 256 * j + 4 * ln_; v[j] = v[j] * rstd * *(const GAS f32x4*)(lg + col) + *(const GAS f32x4*)(lb + col);
            *(GAS f32x4*)(xout + (size_t)row * D + col) = v[j]; }
        if (NEXT != 0 && do_hm) {
            const float* mn = modnext + (size_t)b * 3 * D;
#pragma unroll
            for (int j = 0; j < 8; ++j) { const int col = 256 * j + 4 * ln_; v[j] = v[j] * (*(const GAS f32x4*)(mn + D + col) + 1.f) + *(const GAS f32x4*)(mn + col); }
            if (NEXT == 1) {
#pragma unroll
                for (int j = 0; j < 8; ++j) { v2u o; o.x = pk2(v[j][0], v[j][1]); o.y = pk2(v[j][2], v[j][3]); *(GAS v2u*)(hmb + (size_t)row * D + 256 * j + 4 * ln_) = o; }
            } else {
                float lgt[NE];
#pragma unroll
                for (int e = 0; e < NE; ++e) lgt[e] = 0.f;
#pragma unroll
                for (int j = 0; j < 8; ++j)
#pragma unroll
                    for (int i = 0; i < 4; ++i) { const float* r = rw + (size_t)(256 * j + 4 * ln_ + i) * NE; const f32x4 r0 = *(const GAS f32x4*)r, r1 = *(const GAS f32x4*)(r + 4); const float h = v[j][i];
                        lgt[0] += h * r0[0]; lgt[1] += h * r0[1]; lgt[2] += h * r0[2]; lgt[3] += h * r0[3]; lgt[4] += h * r1[0]; lgt[5] += h * r1[1]; lgt[6] += h * r1[2]; lgt[7] += h * r1[3]; }
#pragma unroll
                for (int e = 0; e < NE; ++e) lgt[e] = wave_sum(lgt[e]);
                int i1 = 0; float v1 = lgt[0];
#pragma unroll
                for (int e = 1; e < NE; ++e) if (lgt[e] > v1) { v1 = lgt[e]; i1 = e; }
                int i2 = 0; float v2 = -3.4e38f;
#pragma unroll
                for (int e = 0; e < NE; ++e) if (e != i1 && lgt[e] > v2) { v2 = lgt[e]; i2 = e; }
                const float w2 = 1.f / (1.f + __expf(v1 - v2)), w1 = 1.f - w2;
                unsigned p1 = 0, p2 = 0;
                if (ln_ == 0) { p1 = __hip_atomic_fetch_add(cnt + 64 * i1, 1u, RLX_AGENT); p2 = __hip_atomic_fetch_add(cnt + 64 * i2, 1u, RLX_AGENT); }
                p1 = (unsigned)__builtin_amdgcn_readfirstlane((int)p1); p2 = (unsigned)__builtin_amdgcn_readfirstlane((int)p2);
                const size_t r1 = (size_t)i1 * CAP + p1, r2 = (size_t)i2 * CAP + p2;
                if (ln_ == 0) { int* rts = (int*)(F.ws + WS_ROWTS); float* rww = (float*)(F.ws + WS_ROWW); rts[r1] = 2 * row; rww[r1] = w1; rts[r2] = 2 * row + 1; rww[r2] = w2; }
#pragma unroll
                for (int j = 0; j < 8; ++j) { v2u o; o.x = pk2(v[j][0], v[j][1]); o.y = pk2(v[j][2], v[j][3]);
                    *(GAS v2u*)(hmb + r1 * D + 256 * j + 4 * ln_) = o; *(GAS v2u*)(hmb + r2 * D + 256 * j + 4 * ln_) = o; }
            }
        }
    }
}
__device__ __forceinline__ void mod_phase(Frame& F, const float* x, const float* mod, bf16* hmb) {
    const int ln_ = pg8::launder(F.lane);
    for (int row = F.gw; row < T; row += F.NGW) { const float* mn = mod + (size_t)(row / S) * 3 * D;
#pragma unroll
        for (int j = 0; j < 8; ++j) { const int col = 256 * j + 4 * ln_; const f32x4 v = *(const GAS f32x4*)(x + (size_t)row * D + col) * (*(const GAS f32x4*)(mn + D + col) + 1.f) + *(const GAS f32x4*)(mn + col);
            v2u o; o.x = pk2(v[0], v[1]); o.y = pk2(v[2], v[3]); *(GAS v2u*)(hmb + (size_t)row * D + col) = o; } }
}
__device__ __forceinline__ void pool_phase(Frame& F, const float* X, const float* mod, bf16* PD) {
    const int ln_ = pg8::launder(F.lane);
    for (int u = F.gw; u < (T / 32) * 8; u += F.NGW) {
        const int chunk = u >> 3, sl = u & 7, t0 = chunk * 32, b = t0 / S, tl0 = t0 % S, col = sl * 256 + 4 * ln_, w = 2 << (sl >> 1);
        const float* mn = mod + (size_t)b * 3 * D; const f32x4 sc = *(const GAS f32x4*)(mn + D + col) + 1.f, sh = *(const GAS f32x4*)(mn + col);
        const float* xp = X + (size_t)t0 * D + col;
        f32x4 sum = (f32x4){0.f, 0.f, 0.f, 0.f};
        for (int jj = 1; jj < w; ++jj) if (tl0 - jj >= 0) sum += *(const GAS f32x4*)(xp - (size_t)jj * D) * sc + sh;
#pragma unroll 4
        for (int i = 0; i < 32; ++i) { const int tl = tl0 + i; const f32x4 h = *(const GAS f32x4*)(xp + (size_t)i * D) * sc + sh; sum += h;
            const int cnt = (tl + 1 < w) ? tl + 1 : w; const f32x4 o = sum * (1.f / (float)cnt) - h;
            v2u ob; ob.x = pk2(o[0], o[1]); ob.y = pk2(o[2], o[3]); *(GAS v2u*)(PD + (size_t)(t0 + i) * D + col) = ob;
            if (tl - w + 1 >= 0) sum -= *(const GAS f32x4*)(xp + (long)(i - w + 1) * D) * sc + sh; }
    }
}
__device__ __forceinline__ void krope_phase(Frame& F) {
    const float* kraw = (const float*)(F.ws + WS_KRAW); const float* cs = (const float*)(F.ws + WS_COS); const float* sn = (const float*)(F.ws + WS_SIN); bf16* krb = (bf16*)(F.ws + WS_KRB);
    for (int i = F.vcu * 512 + pg8::launder(F.tid); i < T * 32; i += F.G * 512) { const int t = i >> 5, f = i & 31; const float x1 = kraw[t * 64 + f], x2 = kraw[t * 64 + 32 + f], c = cs[i], s = sn[i];
        krb[t * 64 + f] = (bf16)(pk2(x1 * c - x2 * s, 0.f) & 0xffffu); krb[t * 64 + 32 + f] = (bf16)(pk2(x1 * s + x2 * c, 0.f) & 0xffffu); }
}
constexpr int NPH_PRE = 2, NPH_PAIR = 15, NPH = NPH_PRE + 2 * NPH_PAIR;
struct Args { const float* in[27]; float* out; unsigned char* ws; int ph_lo, ph_hi; };

__global__ void __launch_bounds__(NWAVES * 64, 2) mega_fwd(Args args) {
    extern __shared__ __attribute__((aligned(16))) unsigned char lds[];
    Frame F;
    F.lds = (LAS unsigned char*)lds; F.MISC = (volatile LAS unsigned*)(F.lds + MISC_OFF);
    F.tid = threadIdx.x; F.lane = F.tid & 63; F.wave = __builtin_amdgcn_readfirstlane(F.tid >> 6);
    F.G = gridDim.x; { const int bx = blockIdx.x; F.vcu = (F.G % 8 == 0) ? (bx % 8) * (F.G / 8) + bx / 8 : bx; }
    F.gw = F.vcu * NWAVES + F.wave; F.NGW = F.G * NWAVES;
    F.ws = args.ws; F.ctl = (gu32*)(args.ws + WS_CTL); F.out = args.out;
    F.in = args.in;
    for (int u = F.tid; u < (LDS_BYTES - LDSCTL_OFF) / 4; u += NWAVES * 64) ((LAS unsigned*)(F.lds + LDSCTL_OFF))[u] = 0u;
    __syncthreads();
    const int lo = args.ph_lo, hi = args.ph_hi; const bool use_bar = (hi - lo) > 1;
    XcdBarrier bar; bar.bar = (unsigned*)(F.ctl + CW_BAR); bar.x = 0; bar.st = nullptr;
    if (use_bar) bar = xcd_barrier_post((unsigned*)(F.ctl + CW_BAR), F.MISC + 8);
#ifndef PH_EN
#define PH_EN 0xFFFFFFFFu
#endif
#define CLS(k) ((k) < NPH_PRE ? (k) : NPH_PRE + ((k) - NPH_PRE) % NPH_PAIR)
#define IN(k) (((PH_EN >> CLS(k)) & 1u) && lo <= (k) && (k) < hi)
#define SEAM(k) do { if (IN(k) && IN((k) + 1)) xcd_barrier(bar); } while (0)
    unsigned char* ws = args.ws;
    float* MOD = (float*)(ws + WS_MOD); float* X = (float*)(ws + WS_X); float* VB = (float*)(ws + WS_VB); bf16* HMb = (bf16*)(ws + WS_HMB); bf16* Wb = (bf16*)(ws + WS_W);
    bf16* CQ = (bf16*)(ws + WS_CQ); bf16* CKV = (bf16*)(ws + WS_CKV); bf16* ZU = (bf16*)(ws + WS_ZU); bf16* ZV = (bf16*)(ws + WS_ZV); bf16* QB = (bf16*)(ws + WS_QB); bf16* KVB = (bf16*)(ws + WS_KVB);
    bf16* CAT = (bf16*)(ws + WS_CAT); bf16* H = (bf16*)(ws + WS_H); bf16* PD = (bf16*)(ws + WS_PD); bf16* PP = (bf16*)(ws + WS_PP); bf16* HMS = (bf16*)(ws + WS_HMS); bf16* HS = (bf16*)(ws + WS_HS);
    float* YS = (float*)(ws + WS_YS); float* SSQQ = (float*)(ws + WS_SSQQ); float* SSQKV = (float*)(ws + WS_SSQKV); float* KRAW = (float*)(ws + WS_KRAW); bf16* KRB = (bf16*)(ws + WS_KRB);
    const float* COS = (const float*)(ws + WS_COS); const float* SIN = (const float*)(ws + WS_SIN);
    const int bx = (int)blockIdx.x;
    LAS int* moetab = (LAS int*)(F.lds + LDSCTL_OFF);
#define MODP(l, s) (MOD + (size_t)((l) * 2 + (s)) * 2 * 3 * D)
#define MOE_TAB(cntp, ncol) do { if (F.tid == 0) { int cum = 0; for (int e = 0; e < NE; ++e) { const int n = (int)__hip_atomic_load((cntp) + 64 * e, RLX_AGENT); const int nr = (n + 255) >> 8; \
        moetab[e] = cum; moetab[9 + e] = nr; cum += nr * (ncol); } moetab[8] = cum; } __syncthreads(); } while (0)

    if (IN(0)) { ada_phase(F); rope_tab_phase(F); convert_even(F, 0); }
    SEAM(0);
    if (IN(1)) { mod_phase(F, F.in[0], MODP(0, 0), HMb); }
    SEAM(1);
    for (int j = 0; j < 2; ++j) {
        const int pb = NPH_PRE + NPH_PAIR * j, l0 = 2 * j, l1 = 2 * j + 1;
        const float* ln_g = F.in[5]; const float* ln_b = F.in[6];
        if (IN(pb + 0)) {
            pg8::StaticOrder So; So.init(T, INWP, F.G, bx, HMb, D, Wb + WE_IN, D);
            pg8::EpiIn E{CQ, CKV, ZU, ZV, KRAW, SSQQ, SSQKV};
            pg8::gemm_phase<pg8::EpiIn, pg8::StaticOrder, true>(F.lds, D, D, D, So, E);
        }
        SEAM(pb + 0);
        if (IN(pb + 1)) {
            krope_phase(F);
            { pg8::StaticOrder So; So.init(T, QW, F.G, bx, CQ, QL, Wb + WE_Q, QL); pg8::EpiQ E{QB, SSQQ, COS, SIN}; pg8::gemm_phase<pg8::EpiQ, pg8::StaticOrder, true>(F.lds, QL, QL, QL, So, E); }
            { pg8::StaticOrder So; So.init(T, KVW, F.G, bx, CKV, KVL, Wb + WE_KV, KVL); pg8::EpiKV E{KVB, SSQKV}; pg8::gemm_phase<pg8::EpiKV, pg8::StaticOrder, true>(F.lds, KVL, KVL, KVL, So, E); }
            const float* sng = F.in[12] + j * SGW; const float* snb = F.in[13] + j * SGW; const float* sw = F.in[14] + (size_t)j * NG * CH * CH; const float* sb = F.in[15] + j * NG * CH;
            const bool fast = (F.G == 256);
            const int nun = fast ? (bx >= 192 ? 5 : 1) : (((T / CH) * NG - bx + F.G - 1) / F.G);
            for (int k = 0; k < nun; ++k) { const int u = fast ? ((bx >= 192 && k < 4) ? (bx - 192) * 4 + k : 256 + bx) : bx + k * F.G;
                sgu::sgu_unit(u >> 3, u & 7, ZU, ZV, sng, snb, sw, sb, CAT, (char*)lds); }
        }
        SEAM(pb + 1);
        if (IN(pb + 2)) {
            for (int it = F.vcu; it < NB * NH * 16; it += F.G) { const int bh = it >> 4, x = it & 15;
                for (int pass = 0; pass < 2; ++pass) attn::attn_block(bh >> 3, bh & 7, pass ? x : 31 - x, QB, KVB, KRB, CAT, (char*)lds); }
        }
        SEAM(pb + 2);
        if (IN(pb + 3)) {
            pg8::StaticOrder So; So.init(T, D, F.G, bx, CAT, 2048, Wb + WE_OUT, 2048);
            pg8::EpiRes E{(j == 0) ? F.in[0] : X, MODP(l0, 0), VB};
            pg8::gemm_phase<pg8::EpiRes, pg8::StaticOrder, true>(F.lds, 2048, 2048, 2048, So, E);
        }
        SEAM(pb + 3);
        if (IN(pb + 4)) ln_phase<0, 1>(F, VB, nullptr, nullptr, nullptr, ln_g + (size_t)(l0 * 2) * D, ln_b + (size_t)(l0 * 2) * D, X, MODP(l0, 1), HMb, nullptr, nullptr, true);
        SEAM(pb + 4);
        if (IN(pb + 5)) {
            pg8::StaticOrder So; So.init(T, 2 * FF, F.G, bx, HMb, D, Wb + WE_GU, D);
            pg8::EpiSwiGLU E{H, FF};
            pg8::gemm_phase<pg8::EpiSwiGLU, pg8::StaticOrder, true>(F.lds, D, D, D, So, E);
        }
        SEAM(pb + 5);
        if (IN(pb + 6)) {
            pg8::StaticOrder So; So.init(T, D, F.G, bx, H, FF, Wb + WE_DN, FF);
            pg8::EpiRes E{X, MODP(l0, 1), VB};
            pg8::gemm_phase<pg8::EpiRes, pg8::StaticOrder, true>(F.lds, FF, FF, FF, So, E);
        }
        SEAM(pb + 6);
        if (IN(pb + 7)) { ln_phase<0, 0>(F, VB, nullptr, nullptr, nullptr, ln_g + (size_t)(l0 * 2 + 1) * D, ln_b + (size_t)(l0 * 2 + 1) * D, X, nullptr, nullptr, nullptr, nullptr, false); convert_odd(F, j); }
        SEAM(pb + 7);
        if (IN(pb + 8)) pool_phase(F, X, MODP(l1, 0), PD);
        SEAM(pb + 8);
        if (IN(pb + 9)) {
            pg8::StaticOrder So; So.init(T, D, F.G, bx, PD, D, Wb + WO_POOL, 512, 1, 512);
            pg8::EpiScaleBf16 E{PP, D, F.in[21] + j * D};
            pg8::gemm_phase<pg8::EpiScaleBf16, pg8::StaticOrder, true>(F.lds, 512, D, 512, So, E);
        }
        SEAM(pb + 9);
        if (IN(pb + 10)) {
            pg8::StaticOrder So; So.init(T, D, F.G, bx, PP, D, Wb + WO_OC, D);
            pg8::EpiRes E{X, MODP(l1, 0), VB};
            pg8::gemm_phase<pg8::EpiRes, pg8::StaticOrder, true>(F.lds, D, D, D, So, E);
        }
        SEAM(pb + 10);
        gu32* mcnt = F.ctl + CW_MOECNT + j * NE * 64;
        if (IN(pb + 11)) ln_phase<0, 2>(F, VB, nullptr, nullptr, nullptr, ln_g + (size_t)(l1 * 2) * D, ln_b + (size_t)(l1 * 2) * D, X, MODP(l1, 1), HMS, F.in[23] + (size_t)j * D * NE, mcnt, true);
        SEAM(pb + 11);
        if (IN(pb + 12)) {
            MOE_TAB(mcnt, 2 * FE / 256);
            pg8::MoeOrder So{(const PG8_LAS int*)moetab, 2 * FE / 256, F.G, bx, (const char*)HMS, (const char*)(Wb + WO_GU), D, D, (size_t)2 * FE * D * 2};
            pg8::EpiSwiGLU E{HS, FE};
            pg8::gemm_phase<pg8::EpiSwiGLU, pg8::MoeOrder, true>(F.lds, D, D, D, So, E);
            __syncthreads();
        }
        SEAM(pb + 12);
        if (IN(pb + 13)) {
            MOE_TAB(mcnt, D / 256);
            pg8::MoeOrder So{(const PG8_LAS int*)moetab, D / 256, F.G, bx, (const char*)HS, (const char*)(Wb + WO_DN), FE, FE, (size_t)D * FE * 2};
            pg8::EpiMoeDown E{YS, (const int*)(ws + WS_ROWTS), (const float*)(ws + WS_ROWW), (const unsigned*)mcnt};
            pg8::gemm_phase<pg8::EpiMoeDown, pg8::MoeOrder, true>(F.lds, FE, FE, FE, So, E);
            __syncthreads();
        }
        SEAM(pb + 13);
        if (IN(pb + 14)) {
            ln_phase<1, 1>(F, nullptr, X, MODP(l1, 1), YS, ln_g + (size_t)(l1 * 2 + 1) * D, ln_b + (size_t)(l1 * 2 + 1) * D, (j == 1) ? F.out : X, MODP((j == 0) ? l1 + 1 : 0, 0), HMb, nullptr, nullptr, j == 0);
            if (j == 0) convert_even(F, 1);
        }
        SEAM(pb + 14);
    }
#undef IN
#undef SEAM
#undef MODP
#undef MOE_TAB
}
#ifndef MEGA_PHASES
#define MEGA_PHASES 32
#endif
#ifndef MEGA_ONE_LAUNCH
#define MEGA_ONE_LAUNCH 1
#endif
constexpr int scaffold_start(int ph) {
    if (ph == 0) return 0;
    for (int j = 0; j < 2; ++j) { const int pb = NPH_PRE + NPH_PAIR * j; if (ph == pb + 5) return 4 * j + 1; if (ph == pb + 8) return 4 * j + 2; if (ph == pb + 12) return 4 * j + 3; if (ph == pb + 15) return 4 * j + 4; }
    return -1;
}
static_assert(scaffold_start(MEGA_PHASES) >= 0, "MEGA_PHASES must end at a sub-layer boundary");

#if MEGA_PHASES < 32
template <int MODE>
static void sgemm(hipStream_t st, const float* A, int lda, const float* W, int ldw, float* C, int ldc, int M, int N, int K, const int* rowidx = nullptr, const int* tile_e = nullptr, size_t wstride = 0) {
    hipLaunchKernelGGL(scaf::k_gemm<MODE>, dim3(N / 64, M / 128), dim3(256), 0, st, A, lda, W, ldw, C, ldc, K, rowidx, tile_e, wstride);
}
static void scaffold_run(void* const* d_in, float* d_out, unsigned char* wsb, int K0, hipStream_t stream) {
    using namespace scaf;
    const float* x_in = (const float*)d_in[0]; const float* c = (const float*)d_in[1]; const int* positions = (const int*)d_in[2];
    const float* ada_w = (const float*)d_in[3]; const float* ada_b = (const float*)d_in[4]; const float* ln_g = (const float*)d_in[5]; const float* ln_b = (const float*)d_in[6];
    const float* w_in_ab = (const float*)d_in[7]; const float* q_norm_g = (const float*)d_in[8]; const float* w_q_up = (const float*)d_in[9]; const float* kv_norm_g = (const float*)d_in[10];
    const float* w_kv_up = (const float*)d_in[11]; const float* sgu_norm_g = (const float*)d_in[12]; const float* sgu_norm_b = (const float*)d_in[13]; const float* sgu_w = (const float*)d_in[14];
    const float* sgu_b = (const float*)d_in[15]; const float* w_out_ab = (const float*)d_in[16]; const float* ffn_w_gate = (const float*)d_in[17]; const float* ffn_w_up = (const float*)d_in[18];
    const float* ffn_w_down = (const float*)d_in[19]; const float* pool_w = (const float*)d_in[20]; const float* pool_scale = (const float*)d_in[21]; const float* w_out_c = (const float*)d_in[22];
    const float* router_w = (const float*)d_in[23]; const float* moe_w_gate = (const float*)d_in[24]; const float* moe_w_up = (const float*)d_in[25]; const float* moe_w_down = (const float*)d_in[26];
    float* X = (float*)(wsb + WS_X);
    float* ws = (float*)(wsb + WS_END); size_t off = 0;
    auto take = [&](size_t n) { float* p = ws + off; off += (n + 63) / 64 * 64; return p; };
    float* MOD = take((size_t)8 * 2 * 3 * D); float* COS = take((size_t)T * 32); float* SIN = take((size_t)T * 32);
    float* HM = take((size_t)T * D); float* Y = take((size_t)T * D);
    int* TOPI = (int*)take((size_t)T * 2); float* TOPW = take((size_t)T * 2); int* ROWIDX = (int*)take(MPAD); int* TILEE = (int*)take(MTILES); int* POS = (int*)take((size_t)T * 2);
    float* ARENA = (float*)(wsb + WS_ACT);
    size_t ao = 0; auto atake = [&](size_t n) { float* p = ARENA + ao; ao += (n + 63) / 64 * 64; return p; };
    float* Z = atake((size_t)T * INW); float* CQN = atake((size_t)T * QL); float* CKVN = atake((size_t)T * KVL); float* Q = atake((size_t)T * QW); float* KV = atake((size_t)T * KVW);
    float* KR = atake((size_t)T * 64); float* U = atake((size_t)T * SGW); float* VG = atake((size_t)T * SGW); float* CAT = atake((size_t)T * 2048);
    float* HG = ARENA; float* HU = ARENA + (size_t)MPAD * FE; float* YS = ARENA + (size_t)2 * MPAD * FE;
    float* PD = ARENA; float* PP = ARENA + (size_t)T * D;
    static_assert((size_t)MPAD * FE >= (size_t)T * FF && ((size_t)2 * MPAD * FE + (size_t)MPAD * D) * 4 <= WS_END - WS_ACT, "arena");
    const int EB = 256; const unsigned gTD = (unsigned)(((size_t)T * D + EB - 1) / EB);
    if (K0 == 0) (void)hipMemcpyAsync(X, x_in, (size_t)T * D * 4, hipMemcpyDeviceToDevice, stream);
    hipLaunchKernelGGL(k_ada, dim3(3 * D / 256, 8), dim3(256), 0, stream, c, ada_w, ada_b, MOD);
    hipLaunchKernelGGL(k_rope_tab, dim3(T * 32 / 256), dim3(256), 0, stream, positions, COS, SIN);
    for (int step = K0; step < 8; ++step) {
        const int l = step >> 1, sl = step & 1, j = l / 2; const float* mod = MOD + (size_t)step * 2 * 3 * D;
        hipLaunchKernelGGL(k_modulate, dim3(gTD), dim3(EB), 0, stream, X, mod, HM);
        if (sl == 0) {
            if ((l & 1) == 0) {
                sgemm<0>(stream, HM, D, w_in_ab + (size_t)j * D * INW, INW, Z, INW, T, INW, D);
                hipLaunchKernelGGL(k_rms, dim3(T), dim3(256), 0, stream, Z, INW, 0, QL, q_norm_g + j * QL, CQN);
                hipLaunchKernelGGL(k_rms, dim3(T), dim3(256), 0, stream, Z, INW, QL, KVL, kv_norm_g + j * KVL, CKVN);
                sgemm<0>(stream, CQN, QL, w_q_up + (size_t)j * QL * QW, QW, Q, QW, T, QW, QL);
                hipLaunchKernelGGL(k_rope_q, dim3(T * NH * 32 / 256), dim3(256), 0, stream, Q, COS, SIN);
                sgemm<0>(stream, CKVN, KVL, w_kv_up + (size_t)j * KVL * KVW, KVW, KV, KVW, T, KVW, KVL);
                hipLaunchKernelGGL(k_rope_k, dim3(T * 32 / 256), dim3(256), 0, stream, Z, KR, COS, SIN);
                hipLaunchKernelGGL(k_attn, dim3(NB * NH * S), dim3(256), 0, stream, Q, KV, KR, CAT);
                hipLaunchKernelGGL(k_sgu_pre, dim3(T * NG * 64 / 256), dim3(256), 0, stream, Z, sgu_norm_g + j * SGW, sgu_norm_b + j * SGW, U, VG);
                hipLaunchKernelGGL(k_sgu_mix, dim3(T * NG), dim3(128), 0, stream, U, VG, sgu_w + (size_t)j * NG * CH * CH, sgu_b + j * NG * CH, CAT);
                sgemm<0>(stream, CAT, 2048, w_out_ab + (size_t)j * 2048 * D, D, Y, D, T, D, 2048);
            } else {
                hipLaunchKernelGGL(k_pool, dim3(gTD), dim3(EB), 0, stream, HM, PD);
                for (int gi = 0; gi < 4; ++gi) sgemm<0>(stream, PD + gi * 512, D, pool_w + ((size_t)j * 4 + gi) * 512 * 512, 512, PP + gi * 512, D, T, 512, 512);
                hipLaunchKernelGGL(k_colscale, dim3(gTD), dim3(EB), 0, stream, PP, pool_scale + j * D);
                sgemm<0>(stream, PP, D, w_out_c + (size_t)j * D * D, D, Y, D, T, D, D);
            }
        } else {
            if ((l & 1) == 0) {
                sgemm<0>(stream, HM, D, ffn_w_gate + (size_t)j * D * FF, FF, HG, FF, T, FF, D);
                sgemm<0>(stream, HM, D, ffn_w_up + (size_t)j * D * FF, FF, HU, FF, T, FF, D);
                hipLaunchKernelGGL(k_swiglu, dim3((unsigned)(((size_t)T * FF + EB - 1) / EB)), dim3(EB), 0, stream, HG, HU, (size_t)T * FF);
                sgemm<0>(stream, HG, FF, ffn_w_down + (size_t)j * FF * D, D, Y, D, T, D, FF);
            } else {
                hipLaunchKernelGGL(k_router, dim3(T * 64 / 256), dim3(256), 0, stream, HM, router_w + (size_t)j * D * NE, TOPI, TOPW);
                hipLaunchKernelGGL(k_sort, dim3(1), dim3(64), 0, stream, TOPI, ROWIDX, TILEE, POS);
                sgemm<1>(stream, HM, D, moe_w_gate + (size_t)j * NE * D * FE, FE, HG, FE, MPAD, FE, D, ROWIDX, TILEE, (size_t)D * FE);
                sgemm<1>(stream, HM, D, moe_w_up + (size_t)j * NE * D * FE, FE, HU, FE, MPAD, FE, D, ROWIDX, TILEE, (size_t)D * FE);
                hipLaunchKernelGGL(k_swiglu, dim3((unsigned)(((size_t)MPAD * FE + EB - 1) / EB)), dim3(EB), 0, stream, HG, HU, (size_t)MPAD * FE);
                sgemm<2>(stream, HG, FE, moe_w_down + (size_t)j * NE * FE * D, D, YS, D, MPAD, D, FE, nullptr, TILEE, (size_t)FE * D);
                hipLaunchKernelGGL(k_moe_combine, dim3(gTD), dim3(EB), 0, stream, YS, POS, TOPW, Y);
            }
        }
        float* xo = (step == 7) ? d_out : X;
        hipLaunchKernelGGL(k_deepnorm, dim3(T), dim3(256), 0, stream, X, Y, mod, ln_g + (size_t)step * D, ln_b + (size_t)step * D, xo);
    }
}

#endif

extern "C" void kernel_launch(void* const* d_in, const int* in_sizes, int n_in, void* d_out, int out_size, void* d_ws, size_t ws_size, hipStream_t stream) {
    (void)in_sizes;
    static int grid = 0;
    if (grid == 0) {
        constexpr size_t need = (MEGA_PHASES == NPH) ? WS_END : WS_END + 160 * MiB;
        if (n_in != 27 || out_size != T * D || ws_size < need) { fprintf(stderr, "kernel_launch: built for 27 inputs, %d outputs, >= %zu bytes of workspace; got n_in %d out %d ws %zu; nothing launched\n", T * D, need, n_in, out_size, ws_size); grid = -1; return; }
        int dev = 0, cus = 0, per_cu = 0;
        if (hipGetDevice(&dev) != hipSuccess || hipDeviceGetAttribute(&cus, hipDeviceAttributeMultiprocessorCount, dev) != hipSuccess) { fprintf(stderr, "kernel_launch: device query failed\n"); grid = -1; return; }
        if (hipFuncSetAttribute((const void*)mega_fwd, hipFuncAttributeMaxDynamicSharedMemorySize, LDS_BYTES) != hipSuccess) { fprintf(stderr, "kernel_launch: hipFuncSetAttribute failed\n"); grid = -1; return; }
        if (hipOccupancyMaxActiveBlocksPerMultiprocessor(&per_cu, (const void*)mega_fwd, NWAVES * 64, LDS_BYTES) != hipSuccess || per_cu < 1)
            fprintf(stderr, "kernel_launch: note: occupancy query reports %d workgroups per CU\n", per_cu);
        (void)hipGetLastError();
        grid = cus;
    }
    if (grid < 0) return;
    if (MEGA_PHASES > 0) {
        if (hipMemsetAsync((char*)d_ws + WS_CTL, 0, CTL_ZERO_BYTES, stream) != hipSuccess) { fprintf(stderr, "kernel_launch: memset failed\n"); return; }
        Args a{};
        for (int i = 0; i < 27; ++i) a.in[i] = (const float*)d_in[i];
        a.out = (float*)d_out; a.ws = (unsigned char*)d_ws;
        if (MEGA_ONE_LAUNCH) { a.ph_lo = 0; a.ph_hi = MEGA_PHASES; hipLaunchKernelGGL(mega_fwd, dim3(grid), dim3(NWAVES * 64), LDS_BYTES, stream, a); }
        else for (int p = 0; p < MEGA_PHASES; ++p) { a.ph_lo = p; a.ph_hi = p + 1; hipLaunchKernelGGL(mega_fwd, dim3(grid), dim3(NWAVES * 64), LDS_BYTES, stream, a); }
        const hipError_t le = hipPeekAtLastError();
        if (le != hipSuccess) fprintf(stderr, "kernel_launch: launch failed: %s\n", hipGetErrorName(le));
    }
#if MEGA_PHASES < 32
    scaffold_run(d_in, (float*)d_out, (unsigned char*)d_ws, scaffold_start(MEGA_PHASES), stream);
#endif
}
```

```cpp
#include <hip/hip_runtime.h>
#include <cstdio>
#include <cstdint>
#define MEGA_PHASES 32
#define MEGA_ONE_LAUNCH 1
namespace {
constexpr int D = 2048, NB = 2, S = 4096, T = NB * S, DEPTH = 4;
constexpr int NH = 8, DN = 128, DR = 64, DV = 128, QL = 768, KVL = 512;
constexpr int SGW = 1024, CH = 128, NG = 8, GD = 128;
constexpr int INW = 3392, INWP = 3584, QW = NH * (DN + DR)  , KVW = NH * (DN + DV)  ;
constexpr int FF = 5632, NE = 8, FE = 2816;
constexpr float ALPHA = 1.681792830507429f;
constexpr float LN_EPS = 1e-5f, RMS_EPS = 1e-6f;
constexpr int CAP = T;
}

namespace pg8 {
#define PG8_LAS __attribute__((address_space(3)))
typedef unsigned short bf16_t;
typedef short bf16x8 __attribute__((ext_vector_type(8)));
typedef float f32x4 __attribute__((ext_vector_type(4)));
typedef float f32x2 __attribute__((ext_vector_type(2)));
typedef unsigned u32x4 __attribute__((ext_vector_type(4)));
typedef unsigned u32x2 __attribute__((ext_vector_type(2)));
constexpr int BM = 256, BK = 64, HALF = 128, HTB = HALF * BK * 2  , STAGE_BYTES = 8 * HTB, NXCD = 8, WGM = 8;

__host__ __device__ __forceinline__ int lds_byte(int r, int c) { const int st = (r >> 4) * 2 + (c >> 5), rr = r & 15, cc = c & 31, ob = rr * 64 + cc * 2; return st * 1024 + (ob ^ (((ob >> 9) & 1) << 5)); }
__host__ __device__ __forceinline__ void stage_rc(int b, int& R, int& C) { const int st = b / 1024, sb = b % 1024, swz = sb ^ (((sb >> 9) & 1) << 5); R = (st >> 1) * 16 + swz / 64; C = (st & 1) * 32 + (swz % 64) / 2; }
__host__ __device__ __forceinline__ int perm32(int rho) { const int n = rho >> 4, i = rho & 15; return 8 * (i >> 2) + 4 * n + (i & 3); }

struct Unit { int pm, pn; const char* A; const char* B; int aux; };

__device__ __forceinline__ int xcd_remap(int L, int nwg) { const int q = nwg / NXCD, r = nwg % NXCD, xcd = L % NXCD, off = L / NXCD; return (xcd < r ? xcd * (q + 1) : r * (q + 1) + (xcd - r) * q) + off; }

struct StaticOrder {
    int nM, nN, nwg, G, c; const char* A; const char* B; int lda, ldb; int a_shift, a_cols;
    __device__ void init(int M, int N, int G_, int c_, const void* A_, int lda_, const void* B_, int ldb_, int a_shift_ = 0, int a_cols_ = 0) {
        nM = M / BM; nN = N / BM; nwg = nM * nN; G = G_; c = c_; A = (const char*)A_; B = (const char*)B_; lda = lda_; ldb = ldb_; a_shift = a_shift_; a_cols = a_cols_; }
    __device__ bool next(int i, Unit& u) const {
        const long L = (long)i * G + c; if (L >= nwg) return false;
        const int wgid = xcd_remap((int)L, nwg);
        const int nig = WGM * nN, gid = wgid / nig, fm = gid * WGM, gsz = (nM - fm) < WGM ? (nM - fm) : WGM;
        u.pm = fm + ((wgid % nig) % gsz); u.pn = (wgid % nig) / gsz; u.aux = 0;
        u.A = A + ((size_t)u.pm * BM * lda + (size_t)((u.pn >> a_shift) * a_cols)) * 2; u.B = B + (size_t)u.pn * BM * ldb * 2; return true;
    }
};
struct MoeOrder {
    const PG8_LAS int* tab; int ncol, G, c; const char* A; const char* B; int lda, ldb; size_t bstride;
    __device__ bool next(int i, Unit& u) const {
        const int nwg = __builtin_amdgcn_readfirstlane(tab[8]); const long L = (long)i * G + c; if (L >= nwg) return false;
        const int id = xcd_remap((int)L, nwg);
        int e = 0;
#pragma unroll
        for (int k = 1; k < 8; ++k) e += (id >= __builtin_amdgcn_readfirstlane(tab[k])) ? 1 : 0;
        const int idx = id - __builtin_amdgcn_readfirstlane(tab[e]), nr = __builtin_amdgcn_readfirstlane(tab[9 + e]), rt = idx % nr, pn = idx / nr;
        u.pm = e * (CAP / BM) + rt; u.pn = pn; u.aux = e;
        u.A = A + (size_t)u.pm * BM * lda * 2; u.B = B + (size_t)e * bstride + (size_t)pn * BM * ldb * 2; return true;
    }
};

__device__ __forceinline__ int launder(int v) { asm volatile("" : "+v"(v)); return v; }
__device__ __forceinline__ unsigned cvt_pk_bf16(float lo, float hi) { unsigned r; asm volatile("v_cvt_pk_bf16_f32 %0, %1, %2" : "=v"(r) : "v"(lo), "v"(hi)); return r; }
__device__ __forceinline__ float silu_f(float v) { return v * __builtin_amdgcn_rcpf(1.f + __builtin_amdgcn_exp2f(-1.4426950408889634f * v)); }
__device__ __forceinline__ float gelu_tanh_f(float v) { const float y = 0.7978845608028654f * (v + 0.044715f * v * v * v); return v * __builtin_amdgcn_rcpf(1.f + __builtin_amdgcn_exp2f(-2.8853900817779268f * y)); }

typedef f32x4 Acc[2][2][4][2];
__device__ __forceinline__ u32x4 pack8(f32x4 v0, f32x4 v1) { u32x4 w; w.x = cvt_pk_bf16(v0[0], v0[1]); w.y = cvt_pk_bf16(v0[2], v0[3]); w.z = cvt_pk_bf16(v1[0], v1[1]); w.w = cvt_pk_bf16(v1[2], v1[3]); return w; }

struct EpiIn {
    static constexpr bool PERM = true;
    bf16_t* CQ; bf16_t* CKV; bf16_t* ZU; bf16_t* ZV; float* KRAW; float* SSQQ; float* SSQKV;
    __device__ __forceinline__ void operator()(const Acc& acc, const Unit& u, int wr, int wc, int fr, int fq) const {
        const int row0 = u.pm * BM + wr * 64 + fr, pn = u.pn;
        if (pn < 5) {
            const bool isq = pn < 3; const int pl = isq ? pn : pn - 3, ld = isq ? QL : KVL; bf16_t* base = (isq ? CQ : CKV) + pl * BM + wc * 32 + 8 * fq;
            float* sq = isq ? SSQQ : SSQKV; const int sld = isq ? 12 : 8;
#pragma unroll
            for (int ai = 0; ai < 2; ++ai)
#pragma unroll
                for (int m = 0; m < 4; ++m) { const int row = row0 + ai * HALF + m * 16; float s = 0.f;
#pragma unroll
                    for (int bj = 0; bj < 2; ++bj) { const f32x4 v0 = acc[ai][bj][m][0], v1 = acc[ai][bj][m][1];
                        s += (v0[0] * v0[0] + v0[1] * v0[1]) + (v0[2] * v0[2] + v0[3] * v0[3]) + (v1[0] * v1[0] + v1[1] * v1[1]) + (v1[2] * v1[2] + v1[3] * v1[3]);
                        *(u32x4*)(base + (size_t)row * ld + bj * HALF) = pack8(v0, v1); }
                    s += __shfl_xor(s, 16); s += __shfl_xor(s, 32);
                    if (fq == 0) sq[(size_t)row * sld + pl * 4 + wc] = s; asm volatile("" ::: "memory"); }
        } else if (pn < 13) {
            const bool isu = pn < 9; const int pl = isu ? pn - 5 : pn - 9; bf16_t* base = (isu ? ZU : ZV) + pl * BM + wc * 32 + 8 * fq;
#pragma unroll
            for (int ai = 0; ai < 2; ++ai)
#pragma unroll
                for (int m = 0; m < 4; ++m) { const int row = row0 + ai * HALF + m * 16;
#pragma unroll
                    for (int bj = 0; bj < 2; ++bj) { f32x4 v0 = acc[ai][bj][m][0], v1 = acc[ai][bj][m][1];
#pragma unroll
                        for (int e = 0; e < 4; ++e) { v0[e] = gelu_tanh_f(v0[e]); v1[e] = gelu_tanh_f(v1[e]); }
                        *(u32x4*)(base + (size_t)row * SGW + bj * HALF) = pack8(v0, v1); } asm volatile("" ::: "memory"); }
        } else {
            if (wc < 2) {
#pragma unroll
                for (int ai = 0; ai < 2; ++ai)
#pragma unroll
                    for (int m = 0; m < 4; ++m) { const int row = row0 + ai * HALF + m * 16; float* p = KRAW + (size_t)row * 64 + wc * 32 + 8 * fq;
                        *(f32x4*)p = acc[ai][0][m][0]; *(f32x4*)(p + 4) = acc[ai][0][m][1]; }
            }
        }
    }
};
__device__ __forceinline__ float row_rs(const float* p, int n4, float inv_n) {
    float s = 0.f;
#pragma unroll
    for (int i = 0; i < 3; ++i) if (i < n4) { const f32x4 v = *(const f32x4*)(p + 4 * i); s += (v[0] + v[1]) + (v[2] + v[3]); }
    return 1.f / sqrtf(s * inv_n + RMS_EPS);
}
struct EpiQ {
    static constexpr bool PERM = true;
    bf16_t* Q; const float* SSQQ; const float* COS; const float* SIN;
    __device__ __forceinline__ void operator()(const Acc& acc, const Unit& u, int wr, int wc, int fr, int fq) const {
        const int row0 = u.pm * BM + wr * 64 + fr, pn = u.pn;
#pragma unroll
        for (int ai = 0; ai < 2; ++ai)
#pragma unroll
            for (int m = 0; m < 4; ++m) { const int row = row0 + ai * HALF + m * 16; const float rs = row_rs(SSQQ + (size_t)row * 12, 3, 1.f / QL);
                if (pn < 4) {
#pragma unroll
                    for (int bj = 0; bj < 2; ++bj) *(u32x4*)(Q + (size_t)row * QW + (2 * pn + bj) * 192 + wc * 32 + 8 * fq) = pack8(acc[ai][bj][m][0] * rs, acc[ai][bj][m][1] * rs);
                } else {
                    const int head = (pn - 4) * 4 + wc; f32x4 o1[2], o2[2];
#pragma unroll
                    for (int n = 0; n < 2; ++n) { const f32x4 c = *(const f32x4*)(COS + (size_t)row * 32 + 8 * fq + 4 * n), s = *(const f32x4*)(SIN + (size_t)row * 32 + 8 * fq + 4 * n);
                        const f32x4 x1 = acc[ai][0][m][n] * rs, x2 = acc[ai][1][m][n] * rs; o1[n] = x1 * c - x2 * s; o2[n] = x1 * s + x2 * c; }
                    bf16_t* p = Q + (size_t)row * QW + head * 192 + 128 + 8 * fq;
                    *(u32x4*)p = pack8(o1[0], o1[1]); *(u32x4*)(p + 32) = pack8(o2[0], o2[1]);
                } asm volatile("" ::: "memory"); }
    }
};
struct EpiKV {
    static constexpr bool PERM = true;
    bf16_t* KV; const float* SSQKV;
    __device__ __forceinline__ void operator()(const Acc& acc, const Unit& u, int wr, int wc, int fr, int fq) const {
        const int row0 = u.pm * BM + wr * 64 + fr;
#pragma unroll
        for (int ai = 0; ai < 2; ++ai)
#pragma unroll
            for (int m = 0; m < 4; ++m) { const int row = row0 + ai * HALF + m * 16; const float rs = row_rs(SSQKV + (size_t)row * 8, 2, 1.f / KVL);
#pragma unroll
                for (int bj = 0; bj < 2; ++bj) *(u32x4*)(KV + (size_t)row * KVW + u.pn * BM + bj * HALF + wc * 32 + 8 * fq) = pack8(acc[ai][bj][m][0] * rs, acc[ai][bj][m][1] * rs); asm volatile("" ::: "memory"); }
    }
};
struct EpiY {
    static constexpr bool PERM = true;
    const float* mod; bf16_t* Y;
    __device__ __forceinline__ void operator()(const Acc& acc, const Unit& u, int wr, int wc, int fr, int fq) const {
        const int row0 = u.pm * BM + wr * 64 + fr, col0 = u.pn * BM + wc * 32 + 8 * fq; const float* gate = mod + (size_t)((u.pm * BM) / S) * 3 * D + 2 * D;
        f32x4 g[2][2];
#pragma unroll
        for (int bj = 0; bj < 2; ++bj)
#pragma unroll
            for (int n = 0; n < 2; ++n) g[bj][n] = *(const f32x4*)(gate + col0 + bj * HALF + 4 * n) + 1.f;
#pragma unroll
        for (int ai = 0; ai < 2; ++ai)
#pragma unroll
            for (int m = 0; m < 4; ++m)
#pragma unroll
                for (int bj = 0; bj < 2; ++bj) *(u32x4*)(Y + (size_t)(row0 + ai * HALF + m * 16) * D + col0 + bj * HALF) = pack8(acc[ai][bj][m][0] * g[bj][0], acc[ai][bj][m][1] * g[bj][1]);
    }
};
struct EpiSwiGLU {
    static constexpr bool PERM = true;
    bf16_t* H; int ldh;
    __device__ __forceinline__ void operator()(const Acc& acc, const Unit& u, int wr, int wc, int fr, int fq) const {
        const int row0 = u.pm * BM + wr * 64 + fr; bf16_t* base = H + u.pn * HALF + wc * 32 + 8 * fq;
#pragma unroll
        for (int ai = 0; ai < 2; ++ai)
#pragma unroll
            for (int m = 0; m < 4; ++m) { f32x4 h0, h1;
#pragma unroll
                for (int e = 0; e < 4; ++e) { h0[e] = silu_f(acc[ai][0][m][0][e]) * acc[ai][1][m][0][e]; h1[e] = silu_f(acc[ai][0][m][1][e]) * acc[ai][1][m][1][e]; }
                *(u32x4*)(base + (size_t)(row0 + ai * HALF + m * 16) * ldh) = pack8(h0, h1); }
    }
};
struct EpiScaleBf16 {
    static constexpr bool PERM = true;
    bf16_t* O; int ldo; const float* scale;
    __device__ __forceinline__ void operator()(const Acc& acc, const Unit& u, int wr, int wc, int fr, int fq) const {
        const int row0 = u.pm * BM + wr * 64 + fr, col0 = u.pn * BM + wc * 32 + 8 * fq;
        f32x4 sc[2][2];
#pragma unroll
        for (int bj = 0; bj < 2; ++bj)
#pragma unroll
            for (int n = 0; n < 2; ++n) sc[bj][n] = *(const f32x4*)(scale + col0 + bj * HALF + 4 * n);
#pragma unroll
        for (int ai = 0; ai < 2; ++ai)
#pragma unroll
            for (int m = 0; m < 4; ++m)
#pragma unroll
                for (int bj = 0; bj < 2; ++bj) *(u32x4*)(O + (size_t)(row0 + ai * HALF + m * 16) * ldo + col0 + bj * HALF) = pack8(acc[ai][bj][m][0] * sc[bj][0], acc[ai][bj][m][1] * sc[bj][1]);
    }
};
struct EpiMoeDown {
    static constexpr bool PERM = true;
    bf16_t* YS; const int* ROWTS; const float* ROWW; const unsigned* cnt;
    __device__ __forceinline__ void operator()(const Acc& acc, const Unit& u, int wr, int wc, int fr, int fq) const {
        const int e = u.aux, n = (int)cnt[64 * e], rl0 = (u.pm - e * (CAP / BM)) * BM + wr * 64 + fr, col0 = u.pn * BM + wc * 32 + 8 * fq;
#pragma unroll
        for (int ai = 0; ai < 2; ++ai)
#pragma unroll
            for (int m = 0; m < 4; ++m) { const int rl = rl0 + ai * HALF + m * 16;
                if (rl < n) { const size_t p = (size_t)e * CAP + rl; const int ts = ROWTS[p]; const float w = ROWW[p]; bf16_t* o = YS + (size_t)ts * D + col0;
#pragma unroll
                    for (int bj = 0; bj < 2; ++bj) *(u32x4*)(o + bj * HALF) = pack8(acc[ai][bj][m][0] * w, acc[ai][bj][m][1] * w); } }
    }
};

__device__ __forceinline__ void glds16s(const char* sbase, unsigned voff, unsigned lds_dst) {
    asm volatile("s_mov_b32 m0, %2\n\ts_nop 0\n\tglobal_load_lds_dwordx4 %0, %1" :: "v"(voff), "s"(sbase), "s"(lds_dst) : "memory");
}
template <class Epi, class Sched, bool ALIGN_EPI>
__device__ __forceinline__ void gemm_phase(PG8_LAS unsigned char* lds, const int K, const int lda, const int ldb, const Sched& S, const Epi& E) {
    const int tid = launder((int)threadIdx.x), wid = __builtin_amdgcn_readfirstlane(tid >> 6), lane = tid & 63, wr = wid >> 2, wc = wid & 3, fr = lane & 15, fq = lane >> 4;
    const int nt = K / BK;
    unsigned voffA[2], voffB[2];
#pragma unroll
    for (int i = 0; i < 2; ++i) { int R, C; stage_rc(tid * 16 + i * 8192, R, C); const int Rb = Epi::PERM ? ((R & ~31) + perm32(R & 31)) : R;
        voffA[i] = (unsigned)(R * lda + C) * 2u; voffB[i] = (unsigned)(Rb * ldb + C) * 2u; }
    const size_t kstep = (size_t)(BK * 2);
    const size_t hA = (size_t)HALF * lda * 2, hB = (size_t)HALF * ldb * 2;
    const unsigned ldsbase = (unsigned)(uintptr_t)lds + (unsigned)wid * 1024u;
    const int aoff = lds_byte(wr * 64 + fr, fq * 8), boff = lds_byte(wc * 32 + fr, fq * 8);
#define PG8_SA(b, h) (((b) * 2 + (h)) * HTB)
#define PG8_SB(b, h) ((4 + (b) * 2 + (h)) * HTB)
#define PG8_STAGE(bufoff, gbase, voff) do { _Pragma("unroll") for (int _i = 0; _i < 2; ++_i) \
        glds16s((const char*)(gbase), (voff)[_i], ldsbase + (unsigned)((bufoff) + _i * 8192)); } while (0)
#define PG8_LDA(dst, b, h) do { _Pragma("unroll") for (int m = 0; m < 4; ++m) _Pragma("unroll") for (int k = 0; k < 2; ++k) dst[m][k] = *(const PG8_LAS bf16x8*)(lds + PG8_SA(b, h) + aoff + m * 2048 + k * 1024); } while (0)
#define PG8_LDB(dst, b, h) do { _Pragma("unroll") for (int n = 0; n < 2; ++n) _Pragma("unroll") for (int k = 0; k < 2; ++k) dst[n][k] = *(const PG8_LAS bf16x8*)(lds + PG8_SB(b, h) + boff + n * 2048 + k * 1024); } while (0)
#define PG8_MMA(ai, bj, At, Bt) do { __builtin_amdgcn_s_setprio(1); _Pragma("unroll") for (int m = 0; m < 4; ++m) _Pragma("unroll") for (int n = 0; n < 2; ++n) _Pragma("unroll") for (int k = 0; k < 2; ++k) \
        acc[ai][bj][m][n] = __builtin_amdgcn_mfma_f32_16x16x32_bf16(Bt[n][k], At[m][k], acc[ai][bj][m][n], 0, 0, 0); __builtin_amdgcn_s_setprio(0); } while (0)
#define PG8_WAIT_V(n) asm volatile("s_waitcnt vmcnt(" #n ")" ::: "memory")
#define PG8_WAIT_L(n) asm volatile("s_waitcnt lgkmcnt(" #n ")" ::: "memory")
#define PG8_BAR __builtin_amdgcn_s_barrier()
#define PG8_SCHED __builtin_amdgcn_sched_barrier(0)
    Unit cur, nxt; int ui = 0;
    if (!S.next(0, cur)) return;
    f32x4 acc[2][2][4][2];
#pragma unroll
    for (int a = 0; a < 2; ++a)
#pragma unroll
        for (int b = 0; b < 2; ++b)
#pragma unroll
            for (int m = 0; m < 4; ++m)
#pragma unroll
                for (int n = 0; n < 2; ++n) acc[a][b][m][n] = (f32x4){0.f, 0.f, 0.f, 0.f};
    bf16x8 At[4][2], B0[2][2], B1[2][2];
    const char* cA = cur.A; const char* cB = cur.B;
    PG8_STAGE(PG8_SB(0, 0), cB, voffB); PG8_STAGE(PG8_SB(0, 1), cB + hB, voffB); PG8_STAGE(PG8_SA(0, 0), cA, voffA); PG8_STAGE(PG8_SA(0, 1), cA + hA, voffA);
    if (wr == 1) PG8_BAR;
    PG8_WAIT_V(2); PG8_BAR;
    PG8_STAGE(PG8_SB(1, 0), cB + kstep, voffB); PG8_STAGE(PG8_SA(1, 0), cA + kstep, voffA); PG8_STAGE(PG8_SB(1, 1), cB + hB + kstep, voffB);
    PG8_WAIT_V(6); PG8_BAR;
    for (;;) {
        const bool has_next = S.next(ui + 1, nxt);
        const char* nA = has_next ? nxt.A : cA; const char* nB = has_next ? nxt.B : cB;
        for (int t = 0; t < nt; t += 2) {
            const bool last = (t == nt - 2);
            const char* a1 = cA + (size_t)(t + 1) * kstep;
            const char* a2 = last ? nA : cA + (size_t)(t + 2) * kstep; const char* b2 = last ? nB : cB + (size_t)(t + 2) * kstep;
            const char* a3 = a2 + kstep; const char* b3 = b2 + kstep;
            PG8_LDB(B0, 0, 0); PG8_LDB(B1, 0, 1); PG8_SCHED; PG8_LDA(At, 0, 0); PG8_STAGE(PG8_SA(1, 1), a1 + hA, voffA);
            PG8_WAIT_V(8); PG8_WAIT_L(0); PG8_BAR; PG8_MMA(0, 0, At, B0); PG8_MMA(0, 1, At, B1); PG8_BAR; PG8_SCHED;
            PG8_LDA(At, 0, 1); PG8_STAGE(PG8_SB(0, 0), b2, voffB); PG8_STAGE(PG8_SB(0, 1), b2 + hB, voffB); PG8_STAGE(PG8_SA(0, 0), a2, voffA);
            PG8_WAIT_V(8); PG8_WAIT_L(0); PG8_BAR; PG8_MMA(1, 0, At, B0); PG8_MMA(1, 1, At, B1); PG8_BAR; PG8_SCHED;
            PG8_LDB(B0, 1, 0); PG8_LDB(B1, 1, 1); PG8_SCHED; PG8_LDA(At, 1, 0); PG8_STAGE(PG8_SA(0, 1), a2 + hA, voffA);
            PG8_WAIT_V(8); PG8_WAIT_L(0); PG8_BAR; PG8_MMA(0, 0, At, B0); PG8_MMA(0, 1, At, B1); PG8_BAR; PG8_SCHED;
            PG8_LDA(At, 1, 1); PG8_STAGE(PG8_SB(1, 0), b3, voffB); PG8_STAGE(PG8_SB(1, 1), b3 + hB, voffB); PG8_STAGE(PG8_SA(1, 0), a3, voffA);
            PG8_WAIT_V(8); PG8_WAIT_L(0); PG8_BAR; PG8_MMA(1, 0, At, B0); PG8_MMA(1, 1, At, B1); PG8_BAR; PG8_SCHED;
        }
        if constexpr (ALIGN_EPI) { if (wr == 0) PG8_BAR; }
        E(acc, cur, wr, wc, fr, fq);
        if (!has_next) break;
#pragma unroll
        for (int a = 0; a < 2; ++a)
#pragma unroll
            for (int b = 0; b < 2; ++b)
#pragma unroll
                for (int m = 0; m < 4; ++m)
#pragma unroll
                    for (int n = 0; n < 2; ++n) acc[a][b][m][n] = (f32x4){0.f, 0.f, 0.f, 0.f};
        cur = nxt; cA = nA; cB = nB; ++ui;
        if constexpr (ALIGN_EPI) { if (wr == 1) PG8_BAR; }
    }
    PG8_WAIT_V(0);
    if constexpr (!ALIGN_EPI) { if (wr == 0) PG8_BAR; }
    PG8_BAR;
#undef PG8_SA
#undef PG8_SB
#undef PG8_STAGE
#undef PG8_LDA
#undef PG8_LDB
#undef PG8_MMA
#undef PG8_WAIT_V
#undef PG8_WAIT_L
#undef PG8_BAR
#undef PG8_SCHED
}
}
namespace attn {
using pg8::bf16_t; using pg8::bf16x8; using pg8::u32x4;
typedef short s16x4 __attribute__((ext_vector_type(4)));
typedef float f32x16 __attribute__((ext_vector_type(16)));
constexpr float SCALE = 0.07216878364870322f;
constexpr float C2 = 1.4426950408889634f * SCALE;
constexpr float THR = 8.f;
constexpr int KVBLK = 64, SHM_V = 16384, SHM_KN = 16384, SHM_KR = 8192;
constexpr int OFF_V = 0, OFF_KN = 2 * SHM_V, OFF_KR = OFF_KN + 2 * SHM_KN, OFF_WS = OFF_KR + 2 * SHM_KR, LDS_BYTES = OFF_WS + 8 * 64 * 4;
#define KSWZ(row, colB) ((row) * 256 + ((colB) ^ (((row) & 7) << 4)))
#define SBAR() __builtin_amdgcn_sched_barrier(0)
__device__ __forceinline__ int v_st(int k, int c) { const int kk = (k & ~0xC) | ((k & 4) << 1) | ((k & 8) >> 1); return ((kk >> 3) * 4 + (c >> 5)) * 512 + ((kk & 7) * 32 + (c & 31)) * 2; }
__device__ __forceinline__ int v_rd_base(int lane) { return ((lane & 3) << 3) | (((lane >> 2) & 3) << 6) | (((lane >> 4) & 1) << 5) | (((lane >> 5) & 1) << 8); }
__device__ __forceinline__ int crow(int r, int hi) { return (r & 3) + 8 * (r >> 2) + 4 * hi; }
__device__ __forceinline__ unsigned cvtpk(float lo, float hi) { unsigned r; asm volatile("v_cvt_pk_bf16_f32 %0, %1, %2" : "=v"(r) : "v"(lo), "v"(hi)); return r; }

__device__ __forceinline__ void mask_tile(f32x16& p, int dq) {
    const float NEG = -__builtin_inff();
#pragma unroll
    for (int r = 0; r < 16; ++r) { const int c = (r & 3) + 8 * (r >> 2); if (dq - c < 0) p[r] = NEG; }
}
__device__ __forceinline__ void partialSM(f32x16& p, float& m_reg, float& alpha) {
    float pmax = p[0];
#pragma unroll
    for (int r = 1; r < 16; ++r) pmax = fmaxf(pmax, p[r]);
    { auto rr = __builtin_amdgcn_permlane32_swap(__float_as_uint(pmax), __float_as_uint(pmax), false, false); pmax = fmaxf(__uint_as_float(rr[0]), __uint_as_float(rr[1])); }
    float mn;
    if (__builtin_expect(__all((pmax - m_reg) * SCALE <= THR), 1)) { mn = m_reg; alpha = 1.f; }
    else { mn = fmaxf(m_reg, pmax); alpha = __builtin_amdgcn_exp2f((m_reg - mn) * C2); m_reg = mn; }
    const float mnL = -mn * C2;
#pragma unroll
    for (int r = 0; r < 16; ++r) p[r] = __builtin_amdgcn_exp2f(fmaf(p[r], C2, mnL));
}
__device__ __forceinline__ void finishSM(const f32x16& p, float alpha, float& l_reg, bf16x8& pa0, bf16x8& pa1) {
    float ps = 0.f;
#pragma unroll
    for (int r = 0; r < 16; ++r) ps += p[r];
    { auto rr = __builtin_amdgcn_permlane32_swap(__float_as_uint(ps), __float_as_uint(ps), false, false); ps = __uint_as_float(rr[0]) + __uint_as_float(rr[1]); }
    l_reg = l_reg * alpha + ps;
#define PK4(P, B_, OUT) do { unsigned a0 = cvtpk(P[B_+0], P[B_+1]), a1 = cvtpk(P[B_+2], P[B_+3]); unsigned b0 = cvtpk(P[B_+4], P[B_+5]), b1 = cvtpk(P[B_+6], P[B_+7]); \
        auto r0 = __builtin_amdgcn_permlane32_swap(a0, b0, false, false); auto r1 = __builtin_amdgcn_permlane32_swap(a1, b1, false, false); \
        u32x4 w = {r0[0], r1[0], r0[1], r1[1]}; OUT = *reinterpret_cast<bf16x8*>(&w); } while (0)
    PK4(p, 0, pa0); PK4(p, 8, pa1);
#undef PK4
}
template <int KB>
__device__ __forceinline__ void qkt(f32x16& p, const char* KN_lds, const char* KR_lds, int par, int r32, int hi, const bf16x8* qr) {
    p = f32x16{};
    const char* kb[4];
#pragma unroll
    for (int dd = 0; dd < 4; ++dd) kb[dd] = KN_lds + KB * SHM_KN + par * (32 * 256) + KSWZ(r32, (dd * 16 + hi * 8) * 2);
#pragma unroll
    for (int d0 = 0; d0 < 8; ++d0) { const bf16x8 a = *reinterpret_cast<const bf16x8*>(kb[d0 & 3] + (d0 >> 2) * 128); p = __builtin_amdgcn_mfma_f32_32x32x16_bf16(a, qr[d0], p, 0, 0, 0); }
    const char* rb = KR_lds + KB * SHM_KR + hi * 1024 + (par * 32 + r32) * 16;
#pragma unroll
    for (int d0 = 0; d0 < 4; ++d0) { const bf16x8 a = *reinterpret_cast<const bf16x8*>(rb + d0 * 2048); p = __builtin_amdgcn_mfma_f32_32x32x16_bf16(a, qr[8 + d0], p, 0, 0, 0); }
}
template <int VB>
__device__ __forceinline__ void pv_tile(f32x16* o, int vbp, bf16x8 pa0, bf16x8 pa1) {
#define TRRD(dst, off) asm volatile("ds_read_b64_tr_b16 %0, %1 offset:%2" : "=&v"(dst) : "v"(vbp), "i"(off) : "memory")
#define PV_D0(d0) do { s16x4 l0, l1, h0, h1; constexpr int b_ = VB * SHM_V + (d0) * 512; \
        TRRD(l0, b_); TRRD(h0, b_ + 2048); TRRD(l1, b_ + 4096); TRRD(h1, b_ + 6144); \
        asm volatile("s_waitcnt lgkmcnt(0)" ::: "memory"); SBAR(); \
        o[d0] = __builtin_amdgcn_mfma_f32_32x32x16_bf16(pa0, (bf16x8){l0[0], l0[1], l0[2], l0[3], h0[0], h0[1], h0[2], h0[3]}, o[d0], 0, 0, 0); \
        o[d0] = __builtin_amdgcn_mfma_f32_32x32x16_bf16(pa1, (bf16x8){l1[0], l1[1], l1[2], l1[3], h1[0], h1[1], h1[2], h1[3]}, o[d0], 0, 0, 0); } while (0)
    PV_D0(0); PV_D0(1); PV_D0(2); PV_D0(3);
#undef PV_D0
#undef TRRD
}

__device__ __forceinline__ void attn_block(int b, int h, int qb, const bf16_t* __restrict__ Qb, const bf16_t* __restrict__ KVb, const bf16_t* __restrict__ KRb, bf16_t* __restrict__ CAT, char* lds) {
    const int tid = pg8::launder((int)threadIdx.x), wid = __builtin_amdgcn_readfirstlane(tid >> 6), lane = tid & 63, r32 = lane & 31, hi = lane >> 5;
    const int rg = wid & 3, par = wid >> 2;
    const size_t rowbase = (size_t)b * S; const int q0 = qb * 128, NT = 2 * (qb + 1);
    char* V_lds = lds + OFF_V; char* KN_lds = lds + OFF_KN; char* KR_lds = lds + OFF_KR;
    float* ws = (float*)(lds + OFF_WS) + wid * 64; float* li_l = ws; float* al_l = ws + 32;
    const int sr = tid >> 4, sc = (tid & 15) * 8, vst0 = v_st(sr, sc), vst1 = v_st(32 + sr, sc), kws = KSWZ(sr, sc * 2);
    const int krow = tid & 63, kch = tid >> 6, krs = kch * 1024 + krow * 16;
    const char* kvu = (const char*)(KVb + rowbase * KVW + h * 256); const char* ru = (const char*)(KRb + rowbase * 64);
    const unsigned lo_kv = (unsigned)(sr * KVW + sc) * 2u, lo_r = (unsigned)(krow * 64 + kch * 8) * 2u;
    const int vbp = (int)(uintptr_t)V_lds + v_rd_base(lane) + par * 8192;
    bf16x8 st_k0, st_k1, st_v0, st_v1, st_r;
#define SLOAD(k0) do { const char* kb_ = kvu + (size_t)(k0) * (KVW * 2); \
        st_v0 = *(const bf16x8*)(kb_ + 256 + (size_t)lo_kv); st_v1 = *(const bf16x8*)(kb_ + 256 + 32 * KVW * 2 + (size_t)lo_kv); \
        st_k0 = *(const bf16x8*)(kb_ + (size_t)lo_kv); st_k1 = *(const bf16x8*)(kb_ + 32 * KVW * 2 + (size_t)lo_kv); st_r = *(const bf16x8*)(ru + (size_t)(k0) * 128 + (size_t)lo_r); } while (0)
#define SWRITE(bf) do { *(bf16x8*)(V_lds + (bf) * SHM_V + vst0) = st_v0; *(bf16x8*)(V_lds + (bf) * SHM_V + vst1) = st_v1; \
        *(bf16x8*)(KN_lds + (bf) * SHM_KN + kws) = st_k0; *(bf16x8*)(KN_lds + (bf) * SHM_KN + kws + 32 * 256) = st_k1; *(bf16x8*)(KR_lds + (bf) * SHM_KR + krs) = st_r; } while (0)
#define VMW() asm volatile("s_waitcnt vmcnt(0)" ::: "memory")
    SLOAD(0);
    bf16x8 qr[12];
    { const char* qu = (const char*)(Qb + (rowbase + q0 + rg * 32) * QW + h * 192); const unsigned lo_q = (unsigned)(r32 * QW + hi * 8) * 2u;
#pragma unroll
      for (int d0 = 0; d0 < 12; ++d0) qr[d0] = *(const bf16x8*)(qu + d0 * 32 + (size_t)lo_q); }
    float m_reg = -1e30f, l_reg = 0.f; f32x16 o[4] = {};
    const int qrel = q0 + rg * 32;
    const int dq0 = qrel + r32 - 32 * par - 4 * hi;
#define MASKT(P, t) do { const int kb_ = 64 * (t) + 32 * par; if (kb_ + 31 > qrel) mask_tile(P, dq0 - 64 * (t)); } while (0)
#define RESC(a) do { if (__any((a) < 1.f)) { if (hi == 0) al_l[r32] = (a); asm volatile("s_waitcnt lgkmcnt(0)" ::: "memory"); \
        _Pragma("unroll") for (int d_ = 0; d_ < 4; ++d_) _Pragma("unroll") for (int r = 0; r < 16; ++r) o[d_][r] *= al_l[crow(r, hi)]; } } while (0)
    f32x16 pA, pB; float alA, alB; bf16x8 pa0, pa1;
    VMW(); SWRITE(0);
    __syncthreads();
    SLOAD(64);
    SBAR(); qkt<0>(pA, KN_lds, KR_lds, par, r32, hi, qr);
    MASKT(pA, 0); partialSM(pA, m_reg, alA);
    VMW(); SWRITE(1);
    __syncthreads();
#define HALF_STEP(PX, alX, PY, alY, t, KB, VB, SB) do { \
        SBAR(); qkt<KB>(PX, KN_lds, KR_lds, par, r32, hi, qr); \
        finishSM(PY, alY, l_reg, pa0, pa1); SBAR(); \
        if ((t) + 1 < NT) { SLOAD(((t) + 1) * 64); SBAR(); } \
        pv_tile<VB>(o, vbp, pa0, pa1); MASKT(PX, (t)); partialSM(PX, m_reg, alX); \
        __syncthreads(); \
        if ((t) + 1 < NT) { VMW(); SWRITE(SB); } \
        RESC(alX); __syncthreads(); } while (0)
    for (int t = 1; t + 1 < NT; t += 2) {
        HALF_STEP(pB, alB, pA, alA, t, 1, 0, 0);
        HALF_STEP(pA, alA, pB, alB, t + 1, 0, 1, 1);
    }
    SBAR(); qkt<1>(pB, KN_lds, KR_lds, par, r32, hi, qr); SBAR();
    finishSM(pA, alA, l_reg, pa0, pa1); SBAR();
    pv_tile<0>(o, vbp, pa0, pa1);
    MASKT(pB, NT - 1); partialSM(pB, m_reg, alB); RESC(alB);
    finishSM(pB, alB, l_reg, pa0, pa1); SBAR(); pv_tile<1>(o, vbp, pa0, pa1);
    __syncthreads();
    float* mo = (float*)lds; float* ml = (float*)(lds + 65536);
    if (par == 1) {
#pragma unroll
        for (int d0 = 0; d0 < 4; ++d0)
#pragma unroll
            for (int r = 0; r < 16; ++r) mo[(rg * 64 + d0 * 16 + r) * 64 + lane] = o[d0][r];
        if (hi == 0) { ml[rg * 64 + r32] = m_reg; ml[rg * 64 + 32 + r32] = l_reg; }
    }
    __syncthreads();
    if (par == 0) {
        const float m1 = ml[rg * 64 + r32], l1 = ml[rg * 64 + 32 + r32];
        const float m = fmaxf(m_reg, m1), a0 = __builtin_amdgcn_exp2f((m_reg - m) * C2), a1 = __builtin_amdgcn_exp2f((m1 - m) * C2);
        const float linv = 1.f / (l_reg * a0 + l1 * a1);
        if (hi == 0) { li_l[r32] = a0 * linv; al_l[r32] = a1 * linv; }
        asm volatile("s_waitcnt lgkmcnt(0)" ::: "memory");
        char* ou = (char*)(CAT + (rowbase + q0 + rg * 32) * 2048 + h * 128); const unsigned lo_o = (unsigned)(4 * hi * 2048 + r32) * 2u;
#pragma unroll
        for (int r = 0; r < 16; ++r) { const int orow = crow(r, hi); const float f0 = li_l[orow], f1 = al_l[orow];
#pragma unroll
            for (int d0 = 0; d0 < 4; ++d0) { const float v = o[d0][r] * f0 + mo[(rg * 64 + d0 * 16 + r) * 64 + lane] * f1; const float vn = __shfl_xor(v, 1);
                if ((r32 & 1) == 0) *(unsigned*)(ou + (((r & 3) + 8 * (r >> 2)) * 4096 + d0 * 64) + (size_t)lo_o) = cvtpk(v, vn); }
            asm volatile("" ::: "memory"); }
    }
    __syncthreads();
#undef SLOAD
#undef SWRITE
#undef VMW
#undef MASKT
#undef RESC
#undef HALF_STEP
}
#undef KSWZ
#undef SBAR
}

namespace sgu {
using pg8::bf16_t; using pg8::bf16x8; using pg8::f32x4; using pg8::u32x4; using pg8::u32x2;
constexpr int VT_PITCH = 272;
constexpr int LDS_BYTES = 128 * VT_PITCH;
__device__ __forceinline__ float bf2f(unsigned short v) { return __uint_as_float((unsigned)v << 16); }
__device__ __forceinline__ void sgu_unit(int n, int g, const bf16_t* __restrict__ ZU, const bf16_t* __restrict__ ZV, const float* __restrict__ ng, const float* __restrict__ nb,
                                         const float* __restrict__ W, const float* __restrict__ bs, bf16_t* __restrict__ CAT, char* lds) {
    const int tid = pg8::launder((int)threadIdx.x), wid = __builtin_amdgcn_readfirstlane(tid >> 6), lane = tid & 63, fr = lane & 15, fq = lane >> 4;
    const size_t t0 = (size_t)n * CH;
    const int row = tid >> 2, q = tid & 3; const char* src = (const char*)(ZV + t0 * SGW + g * GD) + (size_t)((unsigned)(row * SGW + q * 32) * 2u);
    u32x4 zw[4];
#pragma unroll
    for (int i = 0; i < 4; ++i) zw[i] = *(const u32x4*)(src + 16 * i);
    const int tl = wid * 16 + fr;
    const float* wrow = (const float*)((const char*)(W + (size_t)g * CH * CH) + (size_t)((unsigned)(tl * CH + 8 * fq) * 4u));
    f32x4 wraw[4][2];
#pragma unroll
    for (int ks = 0; ks < 4; ++ks) { if (ks * 32 <= wid * 16 + 15) { wraw[ks][0] = *(const f32x4*)(wrow + ks * 32); wraw[ks][1] = *(const f32x4*)(wrow + ks * 32 + 4); } else { wraw[ks][0] = (f32x4){0.f, 0.f, 0.f, 0.f}; wraw[ks][1] = wraw[ks][0]; } }
    const bf16_t* up = (const bf16_t*)((const char*)(ZU + t0 * SGW + g * GD) + (size_t)((unsigned)(tl * SGW + 4 * fq) * 2u)); bf16_t* op = (bf16_t*)((char*)(CAT + t0 * 2048 + 1024 + g * GD) + (size_t)((unsigned)(tl * 2048 + 4 * fq) * 2u));
    u32x2 uw[8];
#pragma unroll
    for (int cb = 0; cb < 8; ++cb) uw[cb] = *(const u32x2*)(up + cb * 16);
    const float bias = bs[g * CH + tl];
    asm volatile("" ::: "memory");
    {
        float v[32];
#pragma unroll
        for (int i = 0; i < 4; ++i) { const u32x4 w = zw[i];
#pragma unroll
            for (int e = 0; e < 4; ++e) { v[8 * i + 2 * e] = __uint_as_float(w[e] << 16); v[8 * i + 2 * e + 1] = __uint_as_float(w[e] & 0xffff0000u); } }
        float s = 0.f;
#pragma unroll
        for (int i = 0; i < 32; ++i) s += v[i];
        s += __shfl_xor(s, 1); s += __shfl_xor(s, 2);
        const float mu = s * (1.f / GD); float qq = 0.f;
#pragma unroll
        for (int i = 0; i < 32; ++i) { v[i] -= mu; qq += v[i] * v[i]; }
        qq += __shfl_xor(qq, 1); qq += __shfl_xor(qq, 2);
        const float rstd = 1.f / sqrtf(qq * (1.f / GD) + LN_EPS);
        const float* gp = (const float*)((const char*)(ng + g * GD) + (size_t)((unsigned)q * 128u)); const float* bp = (const float*)((const char*)(nb + g * GD) + (size_t)((unsigned)q * 128u));
#pragma unroll
        for (int i4 = 0; i4 < 32; i4 += 4) { const f32x4 g4 = *(const f32x4*)(gp + i4), b4 = *(const f32x4*)(bp + i4);
#pragma unroll
            for (int e = 0; e < 4; e += 2) { const int i = i4 + e; const unsigned pk = pg8::cvt_pk_bf16(v[i] * rstd * g4[e] + b4[e], v[i + 1] * rstd * g4[e + 1] + b4[e + 1]);
                *(unsigned short*)(lds + (q * 32 + i) * VT_PITCH + row * 2) = (unsigned short)(pk & 0xffffu); *(unsigned short*)(lds + (q * 32 + i + 1) * VT_PITCH + row * 2) = (unsigned short)(pk >> 16); }
            asm volatile("" ::: "memory"); }
    }
    __syncthreads();
    f32x4 acc[8];
#pragma unroll
    for (int cb = 0; cb < 8; ++cb) acc[cb] = (f32x4){0.f, 0.f, 0.f, 0.f};
#pragma unroll
    for (int ks = 0; ks < 4; ++ks) {
        if (ks * 32 <= wid * 16 + 15) {
            const int s0 = ks * 32 + 8 * fq; const f32x4 w0 = wraw[ks][0], w1 = wraw[ks][1];
            float wv[8] = {w0[0], w0[1], w0[2], w0[3], w1[0], w1[1], w1[2], w1[3]};
#pragma unroll
            for (int e = 0; e < 8; ++e) wv[e] = (s0 + e <= tl) ? wv[e] : 0.f;
            u32x4 wp; wp.x = pg8::cvt_pk_bf16(wv[0], wv[1]); wp.y = pg8::cvt_pk_bf16(wv[2], wv[3]); wp.z = pg8::cvt_pk_bf16(wv[4], wv[5]); wp.w = pg8::cvt_pk_bf16(wv[6], wv[7]);
            const bf16x8 bfrag = *reinterpret_cast<const bf16x8*>(&wp);
#pragma unroll
            for (int cb = 0; cb < 8; ++cb) { const bf16x8 afrag = *(const bf16x8*)(lds + (cb * 16 + fr) * VT_PITCH + s0 * 2);
                acc[cb] = __builtin_amdgcn_mfma_f32_16x16x32_bf16(afrag, bfrag, acc[cb], 0, 0, 0); }
        }
    }
#pragma unroll
    for (int cb = 0; cb < 8; ++cb) { const u32x2 uwv = uw[cb];
        const float u0 = __uint_as_float(uwv.x << 16), u1 = __uint_as_float(uwv.x & 0xffff0000u), u2 = __uint_as_float(uwv.y << 16), u3 = __uint_as_float(uwv.y & 0xffff0000u);
        u32x2 ow; ow.x = pg8::cvt_pk_bf16(u0 * (acc[cb][0] + bias), u1 * (acc[cb][1] + bias)); ow.y = pg8::cvt_pk_bf16(u2 * (acc[cb][2] + bias), u3 * (acc[cb][3] + bias));
        *(u32x2*)(op + cb * 16) = ow; }
    __syncthreads();
}
}
#define GAS __attribute__((address_space(1)))
#define LAS __attribute__((address_space(3)))
typedef unsigned short bf16;
typedef unsigned v4u __attribute__((ext_vector_type(4)));
typedef unsigned v2u __attribute__((ext_vector_type(2)));
typedef float f32x4 __attribute__((ext_vector_type(4)));
typedef GAS unsigned gu32;
#define RLX_AGENT __ATOMIC_RELAXED, __HIP_MEMORY_SCOPE_AGENT
#define LDS_WAIT() asm volatile("s_waitcnt lgkmcnt(0)" ::: "memory")
#define VM_WAIT() asm volatile("s_waitcnt vmcnt(0)" ::: "memory")

constexpr int NWAVES = 8;
constexpr size_t MiB = 1u << 20;
constexpr size_t WS_CTL = 0, CTL_ZERO_BYTES = 1 * MiB;
constexpr size_t WS_MOD = 1 * MiB, WS_COS = 2 * MiB, WS_SIN = 3 * MiB, WS_SSQQ = 4 * MiB, WS_SSQKV = 5 * MiB, WS_KRAW = 6 * MiB, WS_KRB = 8 * MiB, WS_ROWTS = 9 * MiB, WS_ROWW = 10 * MiB;
constexpr size_t WS_X = 16 * MiB, WS_VB = 80 * MiB, WS_HMB = 144 * MiB, WS_WE = 176 * MiB, WS_WO = 276 * MiB, WS_ACT = 564 * MiB, WS_END = 1364 * MiB;
constexpr size_t WS_CQ = WS_ACT, WS_CKV = WS_CQ + 12 * MiB, WS_ZU = WS_CKV + 8 * MiB, WS_ZV = WS_ZU + 16 * MiB, WS_QB = WS_ZV + 16 * MiB, WS_KVB = WS_QB + 24 * MiB, WS_CAT = WS_KVB + 32 * MiB, WS_H = WS_CAT + 32 * MiB;
static_assert(WS_H + (size_t)T * FF * 2 <= WS_END, "even map");
constexpr size_t WS_PD = WS_ACT, WS_PP = WS_PD + 32 * MiB, WS_HMS = WS_PP + 32 * MiB, WS_HS = WS_HMS + (size_t)NE * CAP * D * 2, WS_YS = WS_HS + (size_t)NE * CAP * FE * 2;
static_assert(WS_YS + (size_t)2 * T * D * 4 <= WS_END, "odd map");
constexpr size_t WE_IN = 0, WE_Q = WE_IN + (size_t)INWP * D, WE_KV = WE_Q + (size_t)QW * QL, WE_OUT = WE_KV + (size_t)KVW * KVL, WE_GU = WE_OUT + (size_t)D * D, WE_DN = WE_GU + (size_t)2 * FF * D, WE_END = WE_DN + (size_t)D * FF;
constexpr size_t WO_POOL = 0, WO_OC = WO_POOL + (size_t)D * 512, WO_GU = WO_OC + (size_t)D * D, WO_DN = WO_GU + (size_t)NE * 2 * FE * D, WO_END = WO_DN + (size_t)NE * D * FE;
static_assert(WE_END * 2 <= 100 * MiB && WO_END * 2 <= 288 * MiB, "weight regions");
constexpr int CW_BAR = 4096;
constexpr int CW_MOECNT = 16384;
constexpr int RING_BYTES = 131072, LDSCTL_OFF = RING_BYTES, MISC_OFF = LDSCTL_OFF + 320, LDS_BYTES = 147456;

__device__ __forceinline__ unsigned pk2(float lo, float hi) { return pg8::cvt_pk_bf16(lo, hi); }

#define XB_TMO      128
#define XB_XCNT(j)  (256  + 64 * (j))
#define XB_XSUB(j)  (1280 + 64 * (j))
#define XB_XGEN(j)  (2304 + 64 * (j))
#define XB_TOP      3328
#define XB_TOPGEN   3392
#define XCD_BAR_WORDS 3456
#define XB_SPIN_CAP (1u << 18)
__device__ __forceinline__ unsigned xb_ld(unsigned* p)              { return __hip_atomic_load(p, __ATOMIC_RELAXED, __HIP_MEMORY_SCOPE_AGENT); }
__device__ __forceinline__ unsigned xb_add(unsigned* p, unsigned v) { return __hip_atomic_fetch_add(p, v, __ATOMIC_RELAXED, __HIP_MEMORY_SCOPE_AGENT); }
__device__ __forceinline__ unsigned xb_xcc_id() { return (unsigned)__builtin_amdgcn_s_getreg((3 << 11) | 20) & 0xFu; }
#define XB_SPIN(cond, bar) do { unsigned _sp = 0; while (cond) { __builtin_amdgcn_s_sleep(1); \
    if ((++_sp & 255u) == 0u) { if (xb_ld(&(bar)[XB_TMO])) break; if (_sp > XB_SPIN_CAP) { atomicAdd(&(bar)[XB_TMO], 1u); break; } } } } while (0)
struct XcdBarrier { unsigned* bar; unsigned x; volatile LAS unsigned* st; };
__device__ __forceinline__ XcdBarrier xcd_barrier_post(unsigned* bar, volatile LAS unsigned* st) {
    XcdBarrier b; b.bar = bar; b.x = xb_xcc_id(); b.st = st;
    if (threadIdx.x == 0) (void)xb_add(&bar[XB_XCNT(b.x)], 1u);
    return b;
}
__device__ __forceinline__ void xcd_barrier_complete(unsigned* bar, unsigned x, unsigned& nloc, unsigned& nx) {
    const unsigned G = gridDim.x * gridDim.y * gridDim.z;
    unsigned sum, cnt, mine, sp = 0u;
    for (;;) {
        sum = 0u; cnt = 0u; mine = 0u;
#pragma unroll
        for (unsigned j = 0; j < 16; ++j) { const unsigned c = xb_ld(&bar[XB_XCNT(j)]); sum += c; cnt += (c > 0u) ? 1u : 0u; mine = (j == x) ? c : mine; }
        if (sum == G) break;
        __builtin_amdgcn_s_sleep(1);
        if ((++sp & 255u) == 0u) { if (xb_ld(&bar[XB_TMO])) break; if (sp > XB_SPIN_CAP) { atomicAdd(&bar[XB_TMO], 1u); break; } }
    }
    nloc = mine > 0u ? mine : 1u; nx = cnt > 0u ? cnt : 1u;
}
__device__ __forceinline__ void xcd_barrier(const XcdBarrier& b) {
    asm volatile("s_waitcnt vmcnt(0)" ::: "memory");
    __syncthreads();
    if (threadIdx.x == 0) {
        unsigned* bar = b.bar;
        __builtin_amdgcn_s_waitcnt(0);
        unsigned nloc = b.st[0], nx = b.st[1];
        if (nloc == 0u) { xcd_barrier_complete(bar, b.x, nloc, nx); b.st[0] = nloc; b.st[1] = nx; }
        const unsigned old = xb_add(&bar[XB_XSUB(b.x)], 1u);
        const unsigned gen = old / nloc;
        if (old + 1u == (gen + 1u) * nloc) {
            __builtin_amdgcn_fence(__ATOMIC_RELEASE, "agent");
            asm volatile("s_waitcnt vmcnt(0)" ::: "memory");
            const unsigned og = xb_add(&bar[XB_TOP], 1u);
            const unsigned tg = og / nx;
            if (og + 1u == (tg + 1u) * nx) xb_add(&bar[XB_TOPGEN], 1u);
            else XB_SPIN(xb_ld(&bar[XB_TOPGEN]) == tg, bar);
            __builtin_amdgcn_fence(__ATOMIC_ACQUIRE, "agent");
            xb_add(&bar[XB_XGEN(b.x)], 1u);
            asm volatile("s_waitcnt vmcnt(0)" ::: "memory");
        } else {
            XB_SPIN(xb_ld(&bar[XB_XGEN(b.x)]) == gen, bar);
            __builtin_amdgcn_fence(__ATOMIC_ACQUIRE, "agent");
            asm volatile("s_waitcnt vmcnt(0)" ::: "memory");
        }
    }
    __syncthreads();
}

struct Frame {
    LAS unsigned char* lds; volatile LAS unsigned* MISC; gu32* ctl; unsigned char* ws;
    int tid, lane, wave, vcu, G, gw, NGW;
    const float* const* in; float* out;
};
__device__ __forceinline__ float wave_sum(float v) {
#pragma unroll
    for (int o = 1; o < 64; o <<= 1) v += __shfl_xor(v, o);
    return v;
}
__device__ __forceinline__ void conv_item(const float* W, int N, bf16* WT, int ldk, int dst_row0, const float* kscale, LAS float* scr, int k0, int n0, int lane) {
    const int row = lane >> 3, c4 = lane & 7; const float* src = W + (size_t)(k0 + row) * N + n0 + 4 * c4;
    f32x4 v[8];
#pragma unroll
    for (int i = 0; i < 8; ++i) v[i] = *(const GAS f32x4*)(src + (size_t)(8 * i) * N);
    if (kscale) {
#pragma unroll
        for (int i = 0; i < 8; ++i) v[i] = v[i] * kscale[k0 + row + 8 * i]; }
#pragma unroll
    for (int i = 0; i < 8; ++i) { LAS float* d = scr + (row + 8 * i) * 33 + 4 * c4; d[0] = v[i][0]; d[1] = v[i][1]; d[2] = v[i][2]; d[3] = v[i][3]; }
    LDS_WAIT(); asm volatile("" ::: "memory");
    const int nl = lane & 7, c = lane >> 3;
#pragma unroll
    for (int j = 0; j < 4; ++j) { const int n = nl + 8 * j; const LAS float* s = scr + (8 * c) * 33 + n;
        v4u o; o.x = pk2(s[0 * 33], s[1 * 33]); o.y = pk2(s[2 * 33], s[3 * 33]); o.z = pk2(s[4 * 33], s[5 * 33]); o.w = pk2(s[6 * 33], s[7 * 33]);
        *(GAS v4u*)(WT + (size_t)(dst_row0 + n) * ldk + k0 + 8 * c) = o; }
    LDS_WAIT(); asm volatile("" ::: "memory");
}
template <class RowMap>
__device__ __forceinline__ bool conv_mat(int& it, const float* W, int K, int N, bf16* WT, const float* kscale, LAS float* scr, int lane, RowMap rm) {
    const int nblk = N / 32, cnt = (K / 64) * nblk; if (it >= cnt) { it -= cnt; return false; }
    const int kb = it / nblk, nb = it % nblk; conv_item(W, N, WT, K, rm(nb * 32), kscale, scr, kb * 64, nb * 32, lane); return true;
}
struct RmId { int off; __device__ int operator()(int n0) const { return off + n0; } };
struct RmIn { __device__ int operator()(int n0) const { return n0 < 1280 ? n0 : (n0 < 1344 ? 3328 + (n0 - 1280) : n0 - 64); } };
struct RmQ { __device__ int operator()(int n0) const { const int head = n0 / 192, w = n0 % 192; return w < 128 ? (head >> 1) * 256 + (head & 1) * 128 + w : 1024 + (head >> 2) * 256 + ((w - 128) >> 5) * 128 + (head & 3) * 32; } };
struct RmGU { int up; __device__ int operator()(int n0) const { return (n0 >> 7) * 256 + up * 128 + (n0 & 127); } };

constexpr int NIT_EVEN = (D / 64) * (INW / 32) + (QL / 64) * (QW / 32) + (KVL / 64) * (KVW / 32) + (D / 64) * (D / 32) + 2 * (D / 64) * (FF / 32) + (FF / 64) * (D / 32);
constexpr int NIT_ODD = 4 * (512 / 64) * (512 / 32) + (D / 64) * (D / 32) + NE * (2 * (D / 64) * (FE / 32) + (FE / 64) * (D / 32));
__device__ __forceinline__ void convert_even(Frame& F, int j, int lo, int hi, int w0, int nw) {
    const int ln_ = pg8::launder(F.lane);
    LAS float* scr = (LAS float*)(F.lds + F.wave * 16384); bf16* Wb = (bf16*)(F.ws + WS_WE);
    for (int it0 = lo + w0; it0 < hi; it0 += nw) { int it = it0;
        if (conv_mat(it, F.in[7] + (size_t)j * D * INW, D, INW, Wb + WE_IN, nullptr, scr, ln_, RmIn{})) continue;
        if (conv_mat(it, F.in[9] + (size_t)j * QL * QW, QL, QW, Wb + WE_Q, F.in[8] + j * QL, scr, ln_, RmQ{})) continue;
        if (conv_mat(it, F.in[11] + (size_t)j * KVL * KVW, KVL, KVW, Wb + WE_KV, F.in[10] + j * KVL, scr, ln_, RmId{0})) continue;
        if (conv_mat(it, F.in[16] + (size_t)j * D * D, D, D, Wb + WE_OUT, nullptr, scr, ln_, RmId{0})) continue;
        if (conv_mat(it, F.in[17] + (size_t)j * D * FF, D, FF, Wb + WE_GU, nullptr, scr, ln_, RmGU{0})) continue;
        if (conv_mat(it, F.in[18] + (size_t)j * D * FF, D, FF, Wb + WE_GU, nullptr, scr, ln_, RmGU{1})) continue;
        conv_mat(it, F.in[19] + (size_t)j * FF * D, FF, D, Wb + WE_DN, nullptr, scr, ln_, RmId{0});
    }
}
__device__ __forceinline__ void convert_odd(Frame& F, int j, int lo, int hi, int w0, int nw) {
    const int ln_ = pg8::launder(F.lane);
    LAS float* scr = (LAS float*)(F.lds + F.wave * 16384); bf16* Wb = (bf16*)(F.ws + WS_WO);
    constexpr int NPOOL = (512 / 64) * (512 / 32), NOC = (D / 64) * (D / 32), NGU = (D / 64) * (FE / 32), NDN = (FE / 64) * (D / 32), NEXP = 2 * NGU + NDN;
    static_assert(NIT_ODD == 4 * NPOOL + NOC + NE * NEXP, "item count");
    for (int it0 = lo + w0; it0 < hi; it0 += nw) { int it = it0;
        if (it < 4 * NPOOL) { const int gi = it / NPOOL; it -= gi * NPOOL; conv_mat(it, F.in[20] + ((size_t)j * 4 + gi) * 512 * 512, 512, 512, Wb + WO_POOL, nullptr, scr, ln_, RmId{gi * 512}); continue; }
        it -= 4 * NPOOL;
        if (conv_mat(it, F.in[22] + (size_t)j * D * D, D, D, Wb + WO_OC, nullptr, scr, ln_, RmId{0})) continue;
        const int e = it / NEXP; it -= e * NEXP; const size_t eo = (size_t)j * NE + e;
        if (conv_mat(it, F.in[24] + eo * D * FE, D, FE, Wb + WO_GU + (size_t)e * 2 * FE * D, nullptr, scr, ln_, RmGU{0})) continue;
        if (conv_mat(it, F.in[25] + eo * D * FE, D, FE, Wb + WO_GU + (size_t)e * 2 * FE * D, nullptr, scr, ln_, RmGU{1})) continue;
        conv_mat(it, F.in[26] + eo * FE * D, FE, D, Wb + WO_DN + (size_t)e * D * FE, nullptr, scr, ln_, RmId{0});
    }
}
__device__ __forceinline__ void ada_phase(Frame& F) {
    const int ln_ = pg8::launder(F.lane);
    const float* c = F.in[1]; const float* aw = F.in[3]; const float* ab = F.in[4]; float* MOD = (float*)(F.ws + WS_MOD);
    LAS float* red = (LAS float*)(F.lds);
    for (int u = F.vcu; u < 8 * 96; u += F.G) {
        const int ls = u / 96, n = (u % 96) * 64 + ln_; const float* wp = aw + ((size_t)ls * D + F.wave * 256) * 3 * D + n;
        float a0 = 0.f, a1 = 0.f;
#pragma unroll 16
        for (int k = 0; k < 256; ++k) { const float wv = wp[(size_t)k * 3 * D]; const float c0 = c[F.wave * 256 + k], c1 = c[D + F.wave * 256 + k];
            a0 += pg8::silu_f(c0) * wv; a1 += pg8::silu_f(c1) * wv; }
        red[(F.wave * 2 + 0) * 64 + ln_] = a0; red[(F.wave * 2 + 1) * 64 + ln_] = a1;
        __syncthreads();
        if (F.wave < 2) { float s = 0.f;
#pragma unroll
            for (int w = 0; w < 8; ++w) s += red[(w * 2 + F.wave) * 64 + ln_];
            MOD[((size_t)ls * 2 + F.wave) * 3 * D + n] = s + ab[(size_t)ls * 3 * D + n]; }
        __syncthreads();
    }
}
__device__ const double ROPE_INV[32] = {1.0, 0.7498942093324559, 0.5623413251903491, 0.4216965034285822, 0.31622776601683794, 0.23713737056616552, 0.1778279410038923, 0.1333521432163324, 0.1, 0.07498942093324558, 0.05623413251903491, 0.042169650342858224, 0.03162277660168379, 0.023713737056616554, 0.01778279410038923, 0.01333521432163324, 0.01, 0.007498942093324558, 0.005623413251903491, 0.004216965034285823, 0.0031622776601683794, 0.0023713737056616554, 0.0017782794100389228, 0.001333521432163324, 0.001, 0.0007498942093324559, 0.0005623413251903491, 0.00042169650342858224, 0.00031622776601683794, 0.00023713737056616554, 0.00017782794100389227, 0.0001333521432163324};
__device__ __forceinline__ void rope_tab_phase(Frame& F) {
    const int* pos = (const int*)F.in[2]; float* cs = (float*)(F.ws + WS_COS); float* sn = (float*)(F.ws + WS_SIN);
    for (int i = F.vcu * 512 + pg8::launder(F.tid); i < T * 32; i += F.G * 512) {
        const int t = i >> 5, f = i & 31;
        const double ang = (double)pos[t] * ROPE_INV[f];
        const double kq = __builtin_rint(ang * 0.6366197723675814); const double r = ang - kq * 1.5707963267948966; const double r2 = r * r;
        const double sr = r * (1.0 + r2 * (-1.0 / 6 + r2 * (1.0 / 120 + r2 * (-1.0 / 5040 + r2 * (1.0 / 362880 + r2 * (-1.0 / 39916800 + r2 * (1.0 / 6227020800.0)))))));
        const double cr = 1.0 + r2 * (-0.5 + r2 * (1.0 / 24 + r2 * (-1.0 / 720 + r2 * (1.0 / 40320 + r2 * (-1.0 / 3628800 + r2 * (1.0 / 479001600.0))))));
        const int q = ((int)kq) & 3;
        const double s = (q == 0) ? sr : (q == 1) ? cr : (q == 2) ? -sr : -cr;
        const double cc = (q == 0) ? cr : (q == 1) ? -sr : (q == 2) ? -cr : sr;
        cs[i] = (float)cc; sn[i] = (float)s;
    }
}
template <int MODE, int NEXT>
__device__ __forceinline__ void ln_phase(Frame& F, const float* vsrc, const float* xres, const float* modcur, const float* ys, const float* lg, const float* lb, float* xout,
                                         const float* modnext, bf16* hmb, const float* rw, gu32* cnt, const bool do_hm) {
    const int ln_ = pg8::launder(F.lane);
    for (int row = F.gw; row < T; row += F.NGW) {
        const int b = row / S; f32x4 v[8];
        if (MODE == 0) {
#pragma unroll
            for (int j = 0; j < 8; ++j) { const int col = 256 * j + 4 * ln_; const f32x4 x = *(const GAS f32x4*)(xres + (size_t)row * D + col); const v2u y = *(const GAS v2u*)((const bf16*)vsrc + (size_t)row * D + col);
                v[j] = x * ALPHA + (f32x4){__uint_as_float(y.x << 16), __uint_as_float(y.x & 0xffff0000u), __uint_as_float(y.y << 16), __uint_as_float(y.y & 0xffff0000u)}; }
        } else {
            const float* gate = modcur + (size_t)b * 3 * D + 2 * D; const bf16* ysb = (const bf16*)ys;
#pragma unroll
            for (int j = 0; j < 8; ++j) { const int col = 256 * j + 4 * ln_; const f32x4 x = *(const GAS f32x4*)(xres + (size_t)row * D + col), g = *(const GAS f32x4*)(gate + col);
                const v2u a = *(const GAS v2u*)(ysb + (size_t)(2 * row) * D + col), c = *(const GAS v2u*)(ysb + (size_t)(2 * row + 1) * D + col);
                const f32x4 y = (f32x4){__uint_as_float(a.x << 16) + __uint_as_float(c.x << 16), __uint_as_float(a.x & 0xffff0000u) + __uint_as_float(c.x & 0xffff0000u),
                                        __uint_as_float(a.y << 16) + __uint_as_float(c.y << 16), __uint_as_float(a.y & 0xffff0000u) + __uint_as_float(c.y & 0xffff0000u)};
                v[j] = x * ALPHA + (g + 1.f) * y; }
        }
        float s = 0.f;
#pragma unroll
        for (int j = 0; j < 8; ++j) s += (v[j][0] + v[j][1]) + (v[j][2] + v[j][3]);
        const float mean = wave_sum(s) * (1.f / D); float s2 = 0.f;
#pragma unroll
        for (int j = 0; j < 8; ++j) { v[j] = v[j] - mean; s2 += (v[j][0] * v[j][0] + v[j][1] * v[j][1]) + (v[j][2] * v[j][2] + v[j][3] * v[j][3]); }
        const float rstd = 1.f / sqrtf(wave_sum(s2) * (1.f / D) + LN_EPS);
#pragma unroll
        for (int j = 0; j < 8; ++j) { const int col = 256 * j + 4 * ln_; v[j] = v[j] * rstd * *(const GAS f32x4*)(lg + col) + *(const GAS f32x4*)(lb + col);
            *(GAS f32x4*)(xout + (size_t)row * D + col) = v[j]; }
        if (NEXT != 0 && do_hm) {
            const float* mn = modnext + (size_t)b * 3 * D;
#pragma unroll
            for (int j = 0; j < 8; ++j) { const int col = 256 * j + 4 * ln_; v[j] = v[j] * (*(const GAS f32x4*)(mn + D + col) + 1.f) + *(const GAS f32x4*)(mn + col); }
            if (NEXT == 1) {
#pragma unroll
                for (int j = 0; j < 8; ++j) { v2u o; o.x = pk2(v[j][0], v[j][1]); o.y = pk2(v[j][2], v[j][3]); *(GAS v2u*)(hmb + (size_t)row * D + 256 * j + 4 * ln_) = o; }
            } else {
                float lgt[NE];
#pragma unroll
                for (int e = 0; e < NE; ++e) lgt[e] = 0.f;
#pragma unroll
                for (int j = 0; j < 8; ++j)
#pragma unroll
                    for (int i = 0; i < 4; ++i) { const float* r = rw + (size_t)(256 * j + 4 * ln_ + i) * NE; const f32x4 r0 = *(const GAS f32x4*)r, r1 = *(const GAS f32x4*)(r + 4); const float h = v[j][i];
                        lgt[0] += h * r0[0]; lgt[1] += h * r0[1]; lgt[2] += h * r0[2]; lgt[3] += h * r0[3]; lgt[4] += h * r1[0]; lgt[5] += h * r1[1]; lgt[6] += h * r1[2]; lgt[7] += h * r1[3]; }
#pragma unroll
                for (int e = 0; e < NE; ++e) lgt[e] = wave_sum(lgt[e]);
                int i1 = 0; float v1 = lgt[0];
#pragma unroll
                for (int e = 1; e < NE; ++e) if (lgt[e] > v1) { v1 = lgt[e]; i1 = e; }
                int i2 = 0; float v2 = -3.4e38f;
#pragma unroll
                for (int e = 0; e < NE; ++e) if (e != i1 && lgt[e] > v2) { v2 = lgt[e]; i2 = e; }
                const float w2 = 1.f / (1.f + __expf(v1 - v2)), w1 = 1.f - w2;
                unsigned p1 = 0, p2 = 0;
                if (ln_ == 0) { p1 = __hip_atomic_fetch_add(cnt + 64 * i1, 1u, RLX_AGENT); p2 = __hip_atomic_fetch_add(cnt + 64 * i2, 1u, RLX_AGENT); }
                p1 = (unsigned)__builtin_amdgcn_readfirstlane((int)p1); p2 = (unsigned)__builtin_amdgcn_readfirstlane((int)p2);
                const size_t r1 = (size_t)i1 * CAP + p1, r2 = (size_t)i2 * CAP + p2;
                if (ln_ == 0) { int* rts = (int*)(F.ws + WS_ROWTS); float* rww = (float*)(F.ws + WS_ROWW); rts[r1] = 2 * row; rww[r1] = w1; rts[r2] = 2 * row + 1; rww[r2] = w2; }
#pragma unroll
                for (int j = 0; j < 8; ++j) { v2u o; o.x = pk2(v[j][0], v[j][1]); o.y = pk2(v[j][2], v[j][3]);
                    *(GAS v2u*)(hmb + r1 * D + 256 * j + 4 * ln_) = o; *(GAS v2u*)(hmb + r2 * D + 256 * j + 4 * ln_) = o; }
            }
        }
    }
}
__device__ __forceinline__ void mod_phase(Frame& F, const float* x, const float* mod, bf16* hmb) {
    const int ln_ = pg8::launder(F.lane);
    for (int row = F.gw; row < T; row += F.NGW) { const float* mn = mod + (size_t)(row / S) * 3 * D;
#pragma unroll
        for (int j = 0; j < 8; ++j) { const int col = 256 * j + 4 * ln_; const f32x4 v = *(const GAS f32x4*)(x + (size_t)row * D + col) * (*(const GAS f32x4*)(mn + D + col) + 1.f) + *(const GAS f32x4*)(mn + col);
            v2u o; o.x = pk2(v[0], v[1]); o.y = pk2(v[2], v[3]); *(GAS v2u*)(hmb + (size_t)row * D + col) = o; } }
}
__device__ __forceinline__ void pool_phase(Frame& F, const float* X, const float* mod, bf16* PD) {
    const int ln_ = pg8::launder(F.lane);
    for (int u = F.gw; u < (T / 32) * 8; u += F.NGW) {
        const int chunk = u >> 3, sl = u & 7, t0 = chunk * 32, b = t0 / S, tl0 = t0 % S, col = sl * 256 + 4 * ln_, w = 2 << (sl >> 1);
        const float* mn = mod + (size_t)b * 3 * D; const f32x4 sc = *(const GAS f32x4*)(mn + D + col) + 1.f, sh = *(const GAS f32x4*)(mn + col);
        const float* xp = X + (size_t)t0 * D + col;
        f32x4 sum = (f32x4){0.f, 0.f, 0.f, 0.f};
        for (int jj = 1; jj < w; ++jj) if (tl0 - jj >= 0) sum += *(const GAS f32x4*)(xp - (size_t)jj * D) * sc + sh;
#pragma unroll 4
        for (int i = 0; i < 32; ++i) { const int tl = tl0 + i; const f32x4 h = *(const GAS f32x4*)(xp + (size_t)i * D) * sc + sh; sum += h;
            const int cnt = (tl + 1 < w) ? tl + 1 : w; const f32x4 o = sum * (1.f / (float)cnt) - h;
            v2u ob; ob.x = pk2(o[0], o[1]); ob.y = pk2(o[2], o[3]); *(GAS v2u*)(PD + (size_t)(t0 + i) * D + col) = ob;
            if (tl - w + 1 >= 0) sum -= *(const GAS f32x4*)(xp + (long)(i - w + 1) * D) * sc + sh; }
    }
}
__device__ __forceinline__ void krope_phase(Frame& F) {
    const float* kraw = (const float*)(F.ws + WS_KRAW); const float* cs = (const float*)(F.ws + WS_COS); const float* sn = (const float*)(F.ws + WS_SIN); bf16* krb = (bf16*)(F.ws + WS_KRB);
    for (int i = F.vcu * 512 + pg8::launder(F.tid); i < T * 32; i += F.G * 512) { const int t = i >> 5, f = i & 31; const float x1 = kraw[t * 64 + f], x2 = kraw[t * 64 + 32 + f], c = cs[i], s = sn[i];
        krb[t * 64 + f] = (bf16)(pk2(x1 * c - x2 * s, 0.f) & 0xffffu); krb[t * 64 + 32 + f] = (bf16)(pk2(x1 * s + x2 * c, 0.f) & 0xffffu); }
}
constexpr int NPH_PRE = 2, NPH_PAIR = 15, NPH = NPH_PRE + 2 * NPH_PAIR;
struct Args { const float* in[27]; float* out; unsigned char* ws; int ph_lo, ph_hi; };

__global__ void __launch_bounds__(NWAVES * 64, 2) mega_fwd(Args args) {
    extern __shared__ __attribute__((aligned(16))) unsigned char lds[];
    Frame F;
    F.lds = (LAS unsigned char*)lds; F.MISC = (volatile LAS unsigned*)(F.lds + MISC_OFF);
    F.tid = threadIdx.x; F.lane = F.tid & 63; F.wave = __builtin_amdgcn_readfirstlane(F.tid >> 6);
    F.G = gridDim.x; { const int bx = blockIdx.x; F.vcu = (F.G % 8 == 0) ? (bx % 8) * (F.G / 8) + bx / 8 : bx; }
    F.gw = F.vcu * NWAVES + F.wave; F.NGW = F.G * NWAVES;
    F.ws = args.ws; F.ctl = (gu32*)(args.ws + WS_CTL); F.out = args.out;
    F.in = args.in;
    for (int u = F.tid; u < (LDS_BYTES - LDSCTL_OFF) / 4; u += NWAVES * 64) ((LAS unsigned*)(F.lds + LDSCTL_OFF))[u] = 0u;
    __syncthreads();
    const int lo = args.ph_lo, hi = args.ph_hi; const bool use_bar = (hi - lo) > 1;
    XcdBarrier bar; bar.bar = (unsigned*)(F.ctl + CW_BAR); bar.x = 0; bar.st = nullptr;
    if (use_bar) bar = xcd_barrier_post((unsigned*)(F.ctl + CW_BAR), F.MISC + 8);
#ifndef PH_EN
#define PH_EN 0xFFFFFFFFu
#endif
#define CLS(k) ((k) < NPH_PRE ? (k) : NPH_PRE + ((k) - NPH_PRE) % NPH_PAIR)
#define IN(k) (((PH_EN >> CLS(k)) & 1u) && lo <= (k) && (k) < hi)
#ifndef DUP_CLS
#define DUP_CLS -1
#endif
#ifndef DUP_N
#define DUP_N 1
#endif
#define REP(k) for (int rep_ = 0; rep_ < ((CLS(k) == DUP_CLS) ? DUP_N : 1); ++rep_)
#define SEAM(k) do { if (IN(k) && IN((k) + 1)) xcd_barrier(bar); } while (0)
    unsigned char* ws = args.ws;
    float* MOD = (float*)(ws + WS_MOD); float* X = (float*)(ws + WS_X); float* VB = (float*)(ws + WS_VB); bf16* HMb = (bf16*)(ws + WS_HMB); bf16* WbE = (bf16*)(ws + WS_WE); bf16* WbO = (bf16*)(ws + WS_WO);
    bf16* CQ = (bf16*)(ws + WS_CQ); bf16* CKV = (bf16*)(ws + WS_CKV); bf16* ZU = (bf16*)(ws + WS_ZU); bf16* ZV = (bf16*)(ws + WS_ZV); bf16* QB = (bf16*)(ws + WS_QB); bf16* KVB = (bf16*)(ws + WS_KVB);
    bf16* CAT = (bf16*)(ws + WS_CAT); bf16* H = (bf16*)(ws + WS_H); bf16* PD = (bf16*)(ws + WS_PD); bf16* PP = (bf16*)(ws + WS_PP); bf16* HMS = (bf16*)(ws + WS_HMS); bf16* HS = (bf16*)(ws + WS_HS);
    float* YS = (float*)(ws + WS_YS); float* SSQQ = (float*)(ws + WS_SSQQ); float* SSQKV = (float*)(ws + WS_SSQKV); float* KRAW = (float*)(ws + WS_KRAW); bf16* KRB = (bf16*)(ws + WS_KRB);
    const float* COS = (const float*)(ws + WS_COS); const float* SIN = (const float*)(ws + WS_SIN);
    const int bx = (int)blockIdx.x;
    LAS int* moetab = (LAS int*)(F.lds + LDSCTL_OFF);
#define MODP(l, s) (MOD + (size_t)((l) * 2 + (s)) * 2 * 3 * D)
#define MOE_TAB(cntp, ncol) do { if (F.tid == 0) { int cum = 0; for (int e = 0; e < NE; ++e) { const int n = (int)__hip_atomic_load((cntp) + 64 * e, RLX_AGENT); const int nr = (n + 255) >> 8; \
        moetab[e] = cum; moetab[9 + e] = nr; cum += nr * (ncol); } moetab[8] = cum; } __syncthreads(); } while (0)

#ifndef CV_E1
#define CV_E1 8000
#endif
#ifndef CV_E6
#define CV_E6 16000
#endif
    if (IN(0)) REP(0) { ada_phase(F); rope_tab_phase(F); convert_even(F, 0, 0, NIT_EVEN, F.gw, F.NGW); }
    SEAM(0);
    if (IN(1)) REP(1) { mod_phase(F, F.in[0], MODP(0, 0), HMb); }
    SEAM(1);
    for (int j = 0; j < 2; ++j) {
        const int pb = NPH_PRE + NPH_PAIR * j, l0 = 2 * j, l1 = 2 * j + 1;
        const float* ln_g = F.in[5]; const float* ln_b = F.in[6];
        constexpr int NU1 = (T / 256) * (INWP / 256), NU6 = (T / 256) * (2 * FF / 256);
        const bool has1 = NU1 % F.G != 0, has6 = NU6 % F.G != 0; const int hi1 = has1 ? CV_E1 : 0, hi6 = hi1 + (has6 ? CV_E6 : 0);
        if (IN(pb + 0)) REP(pb + 0) {
            pg8::StaticOrder So; So.init(T, INWP, F.G, bx, HMb, D, WbE + WE_IN, D);
            pg8::EpiIn E{CQ, CKV, ZU, ZV, KRAW, SSQQ, SSQKV};
            pg8::gemm_phase<pg8::EpiIn, pg8::StaticOrder, true>(F.lds, D, D, D, So, E);
            if (has1 && bx >= NU1 % F.G) convert_odd(F, j, 0, hi1, (bx - NU1 % F.G) * NWAVES + F.wave, (F.G - NU1 % F.G) * NWAVES);
        }
        SEAM(pb + 0);
        if (IN(pb + 1)) REP(pb + 1) {
            krope_phase(F);
            { pg8::StaticOrder So; So.init(T, QW, F.G, bx, CQ, QL, WbE + WE_Q, QL); pg8::EpiQ E{QB, SSQQ, COS, SIN}; pg8::gemm_phase<pg8::EpiQ, pg8::StaticOrder, true>(F.lds, QL, QL, QL, So, E); }
            { pg8::StaticOrder So; So.init(T, KVW, F.G, bx, CKV, KVL, WbE + WE_KV, KVL); pg8::EpiKV E{KVB, SSQKV}; pg8::gemm_phase<pg8::EpiKV, pg8::StaticOrder, true>(F.lds, KVL, KVL, KVL, So, E); }
            const float* sng = F.in[12] + j * SGW; const float* snb = F.in[13] + j * SGW; const float* sw = F.in[14] + (size_t)j * NG * CH * CH; const float* sb = F.in[15] + j * NG * CH;
            const bool fast = (F.G == 256);
            const int nun = fast ? (bx >= 192 ? 5 : 1) : (((T / CH) * NG - bx + F.G - 1) / F.G);
            for (int k = 0; k < nun; ++k) { const int u = fast ? ((bx >= 192 && k < 4) ? (bx - 192) * 4 + k : 256 + bx) : bx + k * F.G;
                sgu::sgu_unit(u >> 3, u & 7, ZU, ZV, sng, snb, sw, sb, CAT, (char*)lds); }
        }
        SEAM(pb + 1);
        if (IN(pb + 2)) REP(pb + 2) {
            for (int it = F.vcu; it < NB * NH * 16; it += F.G) { const int bh = it >> 4, x = it & 15;
                for (int pass = 0; pass < 2; ++pass) attn::attn_block(bh >> 3, bh & 7, pass ? x : 31 - x, QB, KVB, KRB, CAT, (char*)lds); }
        }
        SEAM(pb + 2);
        if (IN(pb + 3)) REP(pb + 3) {
            pg8::StaticOrder So; So.init(T, D, F.G, bx, CAT, 2048, WbE + WE_OUT, 2048);
            pg8::EpiY E{MODP(l0, 0), (bf16*)VB};
            pg8::gemm_phase<pg8::EpiY, pg8::StaticOrder, true>(F.lds, 2048, 2048, 2048, So, E);
        }
        SEAM(pb + 3);
        if (IN(pb + 4)) REP(pb + 4) ln_phase<0, 1>(F, VB, (j == 0) ? F.in[0] : X, nullptr, nullptr, ln_g + (size_t)(l0 * 2) * D, ln_b + (size_t)(l0 * 2) * D, X, MODP(l0, 1), HMb, nullptr, nullptr, true);
        SEAM(pb + 4);
        if (IN(pb + 5)) REP(pb + 5) {
            pg8::StaticOrder So; So.init(T, 2 * FF, F.G, bx, HMb, D, WbE + WE_GU, D);
            pg8::EpiSwiGLU E{H, FF};
            pg8::gemm_phase<pg8::EpiSwiGLU, pg8::StaticOrder, true>(F.lds, D, D, D, So, E);
            if (has6 && bx >= NU6 % F.G) convert_odd(F, j, hi1, hi6, (bx - NU6 % F.G) * NWAVES + F.wave, (F.G - NU6 % F.G) * NWAVES);
        }
        SEAM(pb + 5);
        if (IN(pb + 6)) REP(pb + 6) {
            pg8::StaticOrder So; So.init(T, D, F.G, bx, H, FF, WbE + WE_DN, FF);
            pg8::EpiY E{MODP(l0, 1), (bf16*)VB};
            pg8::gemm_phase<pg8::EpiY, pg8::StaticOrder, true>(F.lds, FF, FF, FF, So, E);
        }
        SEAM(pb + 6);
        if (IN(pb + 7)) REP(pb + 7) { ln_phase<0, 0>(F, VB, X, nullptr, nullptr, ln_g + (size_t)(l0 * 2 + 1) * D, ln_b + (size_t)(l0 * 2 + 1) * D, X, nullptr, nullptr, nullptr, nullptr, false); convert_odd(F, j, hi6, NIT_ODD, F.gw, F.NGW); }
        SEAM(pb + 7);
        if (IN(pb + 8)) REP(pb + 8) pool_phase(F, X, MODP(l1, 0), PD);
        SEAM(pb + 8);
        if (IN(pb + 9)) REP(pb + 9) {
            pg8::StaticOrder So; So.init(T, D, F.G, bx, PD, D, WbO + WO_POOL, 512, 1, 512);
            pg8::EpiScaleBf16 E{PP, D, F.in[21] + j * D};
            pg8::gemm_phase<pg8::EpiScaleBf16, pg8::StaticOrder, true>(F.lds, 512, D, 512, So, E);
        }
        SEAM(pb + 9);
        if (IN(pb + 10)) REP(pb + 10) {
            pg8::StaticOrder So; So.init(T, D, F.G, bx, PP, D, WbO + WO_OC, D);
            pg8::EpiY E{MODP(l1, 0), (bf16*)VB};
            pg8::gemm_phase<pg8::EpiY, pg8::StaticOrder, true>(F.lds, D, D, D, So, E);
        }
        SEAM(pb + 10);
        gu32* mcnt = F.ctl + CW_MOECNT + j * NE * 64;
        if (IN(pb + 11)) REP(pb + 11) ln_phase<0, 2>(F, VB, X, nullptr, nullptr, ln_g + (size_t)(l1 * 2) * D, ln_b + (size_t)(l1 * 2) * D, X, MODP(l1, 1), HMS, F.in[23] + (size_t)j * D * NE, mcnt, true);
        SEAM(pb + 11);
        if (IN(pb + 12)) REP(pb + 12) {
            MOE_TAB(mcnt, 2 * FE / 256);
            pg8::MoeOrder So{(const PG8_LAS int*)moetab, 2 * FE / 256, F.G, bx, (const char*)HMS, (const char*)(WbO + WO_GU), D, D, (size_t)2 * FE * D * 2};
            pg8::EpiSwiGLU E{HS, FE};
            pg8::gemm_phase<pg8::EpiSwiGLU, pg8::MoeOrder, true>(F.lds, D, D, D, So, E);
            __syncthreads();
        }
        SEAM(pb + 12);
        if (IN(pb + 13)) REP(pb + 13) {
            MOE_TAB(mcnt, D / 256);
            pg8::MoeOrder So{(const PG8_LAS int*)moetab, D / 256, F.G, bx, (const char*)HS, (const char*)(WbO + WO_DN), FE, FE, (size_t)D * FE * 2};
            pg8::EpiMoeDown E{(bf16*)YS, (const int*)(ws + WS_ROWTS), (const float*)(ws + WS_ROWW), (const unsigned*)mcnt};
            pg8::gemm_phase<pg8::EpiMoeDown, pg8::MoeOrder, true>(F.lds, FE, FE, FE, So, E);
            __syncthreads();
            if (j == 0) { const int nwg = __builtin_amdgcn_readfirstlane(moetab[8]), r3 = nwg - 2 * F.G;
                if (r3 > 0 && r3 < F.G && bx >= r3) convert_even(F, 1, 0, NIT_EVEN, (bx - r3) * NWAVES + F.wave, (F.G - r3) * NWAVES); }
        }
        SEAM(pb + 13);
        if (IN(pb + 14)) REP(pb + 14) {
            ln_phase<1, 1>(F, nullptr, X, MODP(l1, 1), YS, ln_g + (size_t)(l1 * 2 + 1) * D, ln_b + (size_t)(l1 * 2 + 1) * D, (j == 1) ? F.out : X, MODP((j == 0) ? l1 + 1 : 0, 0), HMb, nullptr, nullptr, j == 0);
            if (j == 0) { int nwg = 0; for (int e = 0; e < NE; ++e) nwg += (((int)__hip_atomic_load(mcnt + 64 * e, RLX_AGENT) + 255) >> 8) * (D / 256);
                const int r3 = nwg - 2 * F.G; if (!(r3 > 0 && r3 < F.G)) convert_even(F, 1, 0, NIT_EVEN, F.gw, F.NGW); }
        }
        SEAM(pb + 14);
    }
#undef IN
#undef SEAM
#undef MODP
#undef MOE_TAB
}
#ifndef MEGA_PHASES
#define MEGA_PHASES 32
#endif
#ifndef MEGA_ONE_LAUNCH
#define MEGA_ONE_LAUNCH 1
#endif
constexpr int scaffold_start(int ph) {
    if (ph == 0) return 0;
    for (int j = 0; j < 2; ++j) { const int pb = NPH_PRE + NPH_PAIR * j; if (ph == pb + 5) return 4 * j + 1; if (ph == pb + 8) return 4 * j + 2; if (ph == pb + 12) return 4 * j + 3; if (ph == pb + 15) return 4 * j + 4; }
    return -1;
}
static_assert(scaffold_start(MEGA_PHASES) >= 0, "MEGA_PHASES must end at a sub-layer boundary");

#if MEGA_PHASES < 32
template <int MODE>
static void sgemm(hipStream_t st, const float* A, int lda, const float* W, int ldw, float* C, int ldc, int M, int N, int K, const int* rowidx = nullptr, const int* tile_e = nullptr, size_t wstride = 0) {
    hipLaunchKernelGGL(scaf::k_gemm<MODE>, dim3(N / 64, M / 128), dim3(256), 0, st, A, lda, W, ldw, C, ldc, K, rowidx, tile_e, wstride);
}
static void scaffold_run(void* const* d_in, float* d_out, unsigned char* wsb, int K0, hipStream_t stream) {
    using namespace scaf;
    const float* x_in = (const float*)d_in[0]; const float* c = (const float*)d_in[1]; const int* positions = (const int*)d_in[2];
    const float* ada_w = (const float*)d_in[3]; const float* ada_b = (const float*)d_in[4]; const float* ln_g = (const float*)d_in[5]; const float* ln_b = (const float*)d_in[6];
    const float* w_in_ab = (const float*)d_in[7]; const float* q_norm_g = (const float*)d_in[8]; const float* w_q_up = (const float*)d_in[9]; const float* kv_norm_g = (const float*)d_in[10];
    const float* w_kv_up = (const float*)d_in[11]; const float* sgu_norm_g = (const float*)d_in[12]; const float* sgu_norm_b = (const float*)d_in[13]; const float* sgu_w = (const float*)d_in[14];
    const float* sgu_b = (const float*)d_in[15]; const float* w_out_ab = (const float*)d_in[16]; const float* ffn_w_gate = (const float*)d_in[17]; const float* ffn_w_up = (const float*)d_in[18];
    const float* ffn_w_down = (const float*)d_in[19]; const float* pool_w = (const float*)d_in[20]; const float* pool_scale = (const float*)d_in[21]; const float* w_out_c = (const float*)d_in[22];
    const float* router_w = (const float*)d_in[23]; const float* moe_w_gate = (const float*)d_in[24]; const float* moe_w_up = (const float*)d_in[25]; const float* moe_w_down = (const float*)d_in[26];
    float* X = (float*)(wsb + WS_X);
    float* ws = (float*)(wsb + WS_END); size_t off = 0;
    auto take = [&](size_t n) { float* p = ws + off; off += (n + 63) / 64 * 64; return p; };
    float* MOD = take((size_t)8 * 2 * 3 * D); float* COS = take((size_t)T * 32); float* SIN = take((size_t)T * 32);
    float* HM = take((size_t)T * D); float* Y = take((size_t)T * D);
    int* TOPI = (int*)take((size_t)T * 2); float* TOPW = take((size_t)T * 2); int* ROWIDX = (int*)take(MPAD); int* TILEE = (int*)take(MTILES); int* POS = (int*)take((size_t)T * 2);
    float* ARENA = (float*)(wsb + WS_ACT);
    size_t ao = 0; auto atake = [&](size_t n) { float* p = ARENA + ao; ao += (n + 63) / 64 * 64; return p; };
    float* Z = atake((size_t)T * INW); float* CQN = atake((size_t)T * QL); float* CKVN = atake((size_t)T * KVL); float* Q = atake((size_t)T * QW); float* KV = atake((size_t)T * KVW);
    float* KR = atake((size_t)T * 64); float* U = atake((size_t)T * SGW); float* VG = atake((size_t)T * SGW); float* CAT = atake((size_t)T * 2048);
    float* HG = ARENA; float* HU = ARENA + (size_t)MPAD * FE; float* YS = ARENA + (size_t)2 * MPAD * FE;
    float* PD = ARENA; float* PP = ARENA + (size_t)T * D;
    static_assert((size_t)MPAD * FE >= (size_t)T * FF && ((size_t)2 * MPAD * FE + (size_t)MPAD * D) * 4 <= WS_END - WS_ACT, "arena");
    const int EB = 256; const unsigned gTD = (unsigned)(((size_t)T * D + EB - 1) / EB);
    if (K0 == 0) (void)hipMemcpyAsync(X, x_in, (size_t)T * D * 4, hipMemcpyDeviceToDevice, stream);
    hipLaunchKernelGGL(k_ada, dim3(3 * D / 256, 8), dim3(256), 0, stream, c, ada_w, ada_b, MOD);
    hipLaunchKernelGGL(k_rope_tab, dim3(T * 32 / 256), dim3(256), 0, stream, positions, COS, SIN);
    for (int step = K0; step < 8; ++step) {
        const int l = step >> 1, sl = step & 1, j = l / 2; const float* mod = MOD + (size_t)step * 2 * 3 * D;
        hipLaunchKernelGGL(k_modulate, dim3(gTD), dim3(EB), 0, stream, X, mod, HM);
        if (sl == 0) {
            if ((l & 1) == 0) {
                sgemm<0>(stream, HM, D, w_in_ab + (size_t)j * D * INW, INW, Z, INW, T, INW, D);
                hipLaunchKernelGGL(k_rms, dim3(T), dim3(256), 0, stream, Z, INW, 0, QL, q_norm_g + j * QL, CQN);
                hipLaunchKernelGGL(k_rms, dim3(T), dim3(256), 0, stream, Z, INW, QL, KVL, kv_norm_g + j * KVL, CKVN);
                sgemm<0>(stream, CQN, QL, w_q_up + (size_t)j * QL * QW, QW, Q, QW, T, QW, QL);
                hipLaunchKernelGGL(k_rope_q, dim3(T * NH * 32 / 256), dim3(256), 0, stream, Q, COS, SIN);
                sgemm<0>(stream, CKVN, KVL, w_kv_up + (size_t)j * KVL * KVW, KVW, KV, KVW, T, KVW, KVL);
                hipLaunchKernelGGL(k_rope_k, dim3(T * 32 / 256), dim3(256), 0, stream, Z, KR, COS, SIN);
                hipLaunchKernelGGL(k_attn, dim3(NB * NH * S), dim3(256), 0, stream, Q, KV, KR, CAT);
                hipLaunchKernelGGL(k_sgu_pre, dim3(T * NG * 64 / 256), dim3(256), 0, stream, Z, sgu_norm_g + j * SGW, sgu_norm_b + j * SGW, U, VG);
                hipLaunchKernelGGL(k_sgu_mix, dim3(T * NG), dim3(128), 0, stream, U, VG, sgu_w + (size_t)j * NG * CH * CH, sgu_b + j * NG * CH, CAT);
                sgemm<0>(stream, CAT, 2048, w_out_ab + (size_t)j * 2048 * D, D, Y, D, T, D, 2048);
            } else {
                hipLaunchKernelGGL(k_pool, dim3(gTD), dim3(EB), 0, stream, HM, PD);
                for (int gi = 0; gi < 4; ++gi) sgemm<0>(stream, PD + gi * 512, D, pool_w + ((size_t)j * 4 + gi) * 512 * 512, 512, PP + gi * 512, D, T, 512, 512);
                hipLaunchKernelGGL(k_colscale, dim3(gTD), dim3(EB), 0, stream, PP, pool_scale + j * D);
                sgemm<0>(stream, PP, D, w_out_c + (size_t)j * D * D, D, Y, D, T, D, D);
            }
        } else {
            if ((l & 1) == 0) {
                sgemm<0>(stream, HM, D, ffn_w_gate + (size_t)j * D * FF, FF, HG, FF, T, FF, D);
                sgemm<0>(stream, HM, D, ffn_w_up + (size_t)j * D * FF, FF, HU, FF, T, FF, D);
                hipLaunchKernelGGL(k_swiglu, dim3((unsigned)(((size_t)T * FF + EB - 1) / EB)), dim3(EB), 0, stream, HG, HU, (size_t)T * FF);
                sgemm<0>(stream, HG, FF, ffn_w_down + (size_t)j * FF * D, D, Y, D, T, D, FF);
            } else {
                hipLaunchKernelGGL(k_router, dim3(T * 64 / 256), dim3(256), 0, stream, HM, router_w + (size_t)j * D * NE, TOPI, TOPW);
                hipLaunchKernelGGL(k_sort, dim3(1), dim3(64), 0, stream, TOPI, ROWIDX, TILEE, POS);
                sgemm<1>(stream, HM, D, moe_w_gate + (size_t)j * NE * D * FE, FE, HG, FE, MPAD, FE, D, ROWIDX, TILEE, (size_t)D * FE);
                sgemm<1>(stream, HM, D, moe_w_up + (size_t)j * NE * D * FE, FE, HU, FE, MPAD, FE, D, ROWIDX, TILEE, (size_t)D * FE);
                hipLaunchKernelGGL(k_swiglu, dim3((unsigned)(((size_t)MPAD * FE + EB - 1) / EB)), dim3(EB), 0, stream, HG, HU, (size_t)MPAD * FE);
                sgemm<2>(stream, HG, FE, moe_w_down + (size_t)j * NE * FE * D, D, YS, D, MPAD, D, FE, nullptr, TILEE, (size_t)FE * D);
                hipLaunchKernelGGL(k_moe_combine, dim3(gTD), dim3(EB), 0, stream, YS, POS, TOPW, Y);
            }
        }
        float* xo = (step == 7) ? d_out : X;
        hipLaunchKernelGGL(k_deepnorm, dim3(T), dim3(256), 0, stream, X, Y, mod, ln_g + (size_t)step * D, ln_b + (size_t)step * D, xo);
    }
}

#endif

extern "C" void kernel_launch(void* const* d_in, const int* in_sizes, int n_in, void* d_out, int out_size, void* d_ws, size_t ws_size, hipStream_t stream) {
    (void)in_sizes;
    static int grid = 0;
    if (grid == 0) {
        constexpr size_t need = (MEGA_PHASES == NPH) ? WS_END : WS_END + 160 * MiB;
        if (n_in != 27 || out_size != T * D || ws_size < need) { fprintf(stderr, "kernel_launch: built for 27 inputs, %d outputs, >= %zu bytes of workspace; got n_in %d out %d ws %zu; nothing launched\n", T * D, need, n_in, out_size, ws_size); grid = -1; return; }
        int dev = 0, cus = 0, per_cu = 0;
        if (hipGetDevice(&dev) != hipSuccess || hipDeviceGetAttribute(&cus, hipDeviceAttributeMultiprocessorCount, dev) != hipSuccess) { fprintf(stderr, "kernel_launch: device query failed\n"); grid = -1; return; }
        if (hipFuncSetAttribute((const void*)mega_fwd, hipFuncAttributeMaxDynamicSharedMemorySize, LDS_BYTES) != hipSuccess) { fprintf(stderr, "kernel_launch: hipFuncSetAttribute failed\n"); grid = -1; return; }
        if (hipOccupancyMaxActiveBlocksPerMultiprocessor(&per_cu, (const void*)mega_fwd, NWAVES * 64, LDS_BYTES) != hipSuccess || per_cu < 1)
            fprintf(stderr, "kernel_launch: note: occupancy query reports %d workgroups per CU\n", per_cu);
        (void)hipGetLastError();
        grid = cus;
    }
    if (grid < 0) return;
    if (MEGA_PHASES > 0) {
        if (hipMemsetAsync((char*)d_ws + WS_CTL, 0, CTL_ZERO_BYTES, stream) != hipSuccess) { fprintf(stderr, "kernel_launch: memset failed\n"); return; }
        Args a{};
        for (int i = 0; i < 27; ++i) a.in[i] = (const float*)d_in[i];
        a.out = (float*)d_out; a.ws = (unsigned char*)d_ws;
        if (MEGA_ONE_LAUNCH) { a.ph_lo = 0; a.ph_hi = MEGA_PHASES; hipLaunchKernelGGL(mega_fwd, dim3(grid), dim3(NWAVES * 64), LDS_BYTES, stream, a); }
        else for (int p = 0; p < MEGA_PHASES; ++p) { a.ph_lo = p; a.ph_hi = p + 1; hipLaunchKernelGGL(mega_fwd, dim3(grid), dim3(NWAVES * 64), LDS_BYTES, stream, a); }
        const hipError_t le = hipPeekAtLastError();
        if (le != hipSuccess) fprintf(stderr, "kernel_launch: launch failed: %s\n", hipGetErrorName(le));
    }
#if MEGA_PHASES < 32
    scaffold_run(d_in, (float*)d_out, (unsigned char*)d_ws, scaffold_start(MEGA_PHASES), stream);
#endif
}
```

```cpp
#include <hip/hip_runtime.h>
#include <cstdio>
#include <cstdint>
#define MEGA_PHASES 32
#define MEGA_ONE_LAUNCH 1
namespace {
constexpr int D = 2048, NB = 2, S = 4096, T = NB * S, DEPTH = 4;
constexpr int NH = 8, DN = 128, DR = 64, DV = 128, QL = 768, KVL = 512;
constexpr int SGW = 1024, CH = 128, NG = 8, GD = 128;
constexpr int INW = 3392, INWP = 3584, QW = NH * (DN + DR)  , KVW = NH * (DN + DV)  ;
constexpr int FF = 5632, NE = 8, FE = 2816;
constexpr float ALPHA = 1.681792830507429f;
constexpr float LN_EPS = 1e-5f, RMS_EPS = 1e-6f;
constexpr int CAP = T;
}

namespace pg8 {
#define PG8_LAS __attribute__((address_space(3)))
typedef unsigned short bf16_t;
typedef short bf16x8 __attribute__((ext_vector_type(8)));
typedef float f32x4 __attribute__((ext_vector_type(4)));
typedef float f32x2 __attribute__((ext_vector_type(2)));
typedef unsigned u32x4 __attribute__((ext_vector_type(4)));
typedef unsigned u32x2 __attribute__((ext_vector_type(2)));
constexpr int BM = 256, BK = 64, HALF = 128, HTB = HALF * BK * 2  , STAGE_BYTES = 8 * HTB, NXCD = 8, WGM = 8;

__host__ __device__ __forceinline__ int lds_byte(int r, int c) { const int st = (r >> 4) * 2 + (c >> 5), rr = r & 15, cc = c & 31, ob = rr * 64 + cc * 2; return st * 1024 + (ob ^ (((ob >> 9) & 1) << 5)); }
__host__ __device__ __forceinline__ void stage_rc(int b, int& R, int& C) { const int st = b / 1024, sb = b % 1024, swz = sb ^ (((sb >> 9) & 1) << 5); R = (st >> 1) * 16 + swz / 64; C = (st & 1) * 32 + (swz % 64) / 2; }
__host__ __device__ __forceinline__ int perm32(int rho) { const int n = rho >> 4, i = rho & 15; return 8 * (i >> 2) + 4 * n + (i & 3); }

struct Unit { int pm, pn; const char* A; const char* B; int aux; };

__device__ __forceinline__ int xcd_remap(int L, int nwg) { const int q = nwg / NXCD, r = nwg % NXCD, xcd = L % NXCD, off = L / NXCD; return (xcd < r ? xcd * (q + 1) : r * (q + 1) + (xcd - r) * q) + off; }

struct StaticOrder {
    int nM, nN, nwg, G, c; const char* A; const char* B; int lda, ldb; int a_shift, a_cols;
    __device__ void init(int M, int N, int G_, int c_, const void* A_, int lda_, const void* B_, int ldb_, int a_shift_ = 0, int a_cols_ = 0) {
        nM = M / BM; nN = N / BM; nwg = nM * nN; G = G_; c = c_; A = (const char*)A_; B = (const char*)B_; lda = lda_; ldb = ldb_; a_shift = a_shift_; a_cols = a_cols_; }
    __device__ bool next(int i, Unit& u) const {
        const long L = (long)i * G + c; if (L >= nwg) return false;
        const int wgid = xcd_remap((int)L, nwg);
        const int nig = WGM * nN, gid = wgid / nig, fm = gid * WGM, gsz = (nM - fm) < WGM ? (nM - fm) : WGM;
        u.pm = fm + ((wgid % nig) % gsz); u.pn = (wgid % nig) / gsz; u.aux = 0;
        u.A = A + ((size_t)u.pm * BM * lda + (size_t)((u.pn >> a_shift) * a_cols)) * 2; u.B = B + (size_t)u.pn * BM * ldb * 2; return true;
    }
};
struct MoeOrder {
    const PG8_LAS int* tab; int ncol, G, c; const char* A; const char* B; int lda, ldb; size_t bstride;
    __device__ bool next(int i, Unit& u) const {
        const int nwg = __builtin_amdgcn_readfirstlane(tab[8]); const long L = (long)i * G + c; if (L >= nwg) return false;
        const int id = xcd_remap((int)L, nwg);
        int e = 0;
#pragma unroll
        for (int k = 1; k < 8; ++k) e += (id >= __builtin_amdgcn_readfirstlane(tab[k])) ? 1 : 0;
        const int idx = id - __builtin_amdgcn_readfirstlane(tab[e]), nr = __builtin_amdgcn_readfirstlane(tab[9 + e]), rt = idx % nr, pn = idx / nr;
        u.pm = e * (CAP / BM) + rt; u.pn = pn; u.aux = e;
        u.A = A + (size_t)u.pm * BM * lda * 2; u.B = B + (size_t)e * bstride + (size_t)pn * BM * ldb * 2; return true;
    }
};

__device__ __forceinline__ int launder(int v) { asm volatile("" : "+v"(v)); return v; }
__device__ __forceinline__ unsigned cvt_pk_bf16(float lo, float hi) { unsigned r; asm volatile("v_cvt_pk_bf16_f32 %0, %1, %2" : "=v"(r) : "v"(lo), "v"(hi)); return r; }
__device__ __forceinline__ float silu_f(float v) { return v * __builtin_amdgcn_rcpf(1.f + __builtin_amdgcn_exp2f(-1.4426950408889634f * v)); }
__device__ __forceinline__ float gelu_tanh_f(float v) { const float y = 0.7978845608028654f * (v + 0.044715f * v * v * v); return v * __builtin_amdgcn_rcpf(1.f + __builtin_amdgcn_exp2f(-2.8853900817779268f * y)); }

typedef f32x4 Acc[2][2][4][2];
#ifndef EPI_WT
#define EPI_WT 0
#endif
__device__ __forceinline__ void st16(void* p, u32x4 v) {
#if EPI_WT
    asm volatile("global_store_dwordx4 %0, %1, off sc1" :: "v"(p), "v"(v) : "memory");
#else
    *(u32x4*)p = v;
#endif
}
__device__ __forceinline__ u32x4 pack8(f32x4 v0, f32x4 v1) { u32x4 w; w.x = cvt_pk_bf16(v0[0], v0[1]); w.y = cvt_pk_bf16(v0[2], v0[3]); w.z = cvt_pk_bf16(v1[0], v1[1]); w.w = cvt_pk_bf16(v1[2], v1[3]); return w; }

struct EpiIn {
    static constexpr bool PERM = true;
    bf16_t* CQ; bf16_t* CKV; bf16_t* ZU; bf16_t* ZV; float* KRAW; float* SSQQ; float* SSQKV;
    __device__ __forceinline__ void operator()(const Acc& acc, const Unit& u, int wr, int wc, int fr, int fq) const {
        const int row0 = u.pm * BM + wr * 64 + fr, pn = u.pn;
        if (pn < 5) {
            const bool isq = pn < 3; const int pl = isq ? pn : pn - 3, ld = isq ? QL : KVL; bf16_t* base = (isq ? CQ : CKV) + pl * BM + wc * 32 + 8 * fq;
            float* sq = isq ? SSQQ : SSQKV; const int sld = isq ? 12 : 8;
#pragma unroll
            for (int ai = 0; ai < 2; ++ai)
#pragma unroll
                for (int m = 0; m < 4; ++m) { const int row = row0 + ai * HALF + m * 16; float s = 0.f;
#pragma unroll
                    for (int bj = 0; bj < 2; ++bj) { const f32x4 v0 = acc[ai][bj][m][0], v1 = acc[ai][bj][m][1];
                        s += (v0[0] * v0[0] + v0[1] * v0[1]) + (v0[2] * v0[2] + v0[3] * v0[3]) + (v1[0] * v1[0] + v1[1] * v1[1]) + (v1[2] * v1[2] + v1[3] * v1[3]);
                        st16(base + (size_t)row * ld + bj * HALF, pack8(v0, v1)); }
                    s += __shfl_xor(s, 16); s += __shfl_xor(s, 32);
                    if (fq == 0) sq[(size_t)row * sld + pl * 4 + wc] = s; asm volatile("" ::: "memory"); }
        } else if (pn < 13) {
            const bool isu = pn < 9; const int pl = isu ? pn - 5 : pn - 9; bf16_t* base = (isu ? ZU : ZV) + pl * BM + wc * 32 + 8 * fq;
#pragma unroll
            for (int ai = 0; ai < 2; ++ai)
#pragma unroll
                for (int m = 0; m < 4; ++m) { const int row = row0 + ai * HALF + m * 16;
#pragma unroll
                    for (int bj = 0; bj < 2; ++bj) { f32x4 v0 = acc[ai][bj][m][0], v1 = acc[ai][bj][m][1];
#pragma unroll
                        for (int e = 0; e < 4; ++e) { v0[e] = gelu_tanh_f(v0[e]); v1[e] = gelu_tanh_f(v1[e]); }
                        st16(base + (size_t)row * SGW + bj * HALF, pack8(v0, v1)); } asm volatile("" ::: "memory"); }
        } else {
            if (wc < 2) {
#pragma unroll
                for (int ai = 0; ai < 2; ++ai)
#pragma unroll
                    for (int m = 0; m < 4; ++m) { const int row = row0 + ai * HALF + m * 16; float* p = KRAW + (size_t)row * 64 + wc * 32 + 8 * fq;
                        *(f32x4*)p = acc[ai][0][m][0]; *(f32x4*)(p + 4) = acc[ai][0][m][1]; }
            }
        }
    }
};
__device__ __forceinline__ float row_rs(const float* p, int n4, float inv_n) {
    float s = 0.f;
#pragma unroll
    for (int i = 0; i < 3; ++i) if (i < n4) { const f32x4 v = *(const f32x4*)(p + 4 * i); s += (v[0] + v[1]) + (v[2] + v[3]); }
    return 1.f / sqrtf(s * inv_n + RMS_EPS);
}
struct EpiQ {
    static constexpr bool PERM = true;
    bf16_t* Q; const float* SSQQ; const float* COS; const float* SIN;
    __device__ __forceinline__ void operator()(const Acc& acc, const Unit& u, int wr, int wc, int fr, int fq) const {
        const int row0 = u.pm * BM + wr * 64 + fr, pn = u.pn;
#pragma unroll
        for (int ai = 0; ai < 2; ++ai)
#pragma unroll
            for (int m = 0; m < 4; ++m) { const int row = row0 + ai * HALF + m * 16; const float rs = row_rs(SSQQ + (size_t)row * 12, 3, 1.f / QL);
                if (pn < 4) {
#pragma unroll
                    for (int bj = 0; bj < 2; ++bj) st16(Q + (size_t)row * QW + (2 * pn + bj) * 192 + wc * 32 + 8 * fq, pack8(acc[ai][bj][m][0] * rs, acc[ai][bj][m][1] * rs));
                } else {
                    const int head = (pn - 4) * 4 + wc; f32x4 o1[2], o2[2];
#pragma unroll
                    for (int n = 0; n < 2; ++n) { const f32x4 c = *(const f32x4*)(COS + (size_t)row * 32 + 8 * fq + 4 * n), s = *(const f32x4*)(SIN + (size_t)row * 32 + 8 * fq + 4 * n);
                        const f32x4 x1 = acc[ai][0][m][n] * rs, x2 = acc[ai][1][m][n] * rs; o1[n] = x1 * c - x2 * s; o2[n] = x1 * s + x2 * c; }
                    bf16_t* p = Q + (size_t)row * QW + head * 192 + 128 + 8 * fq;
                    *(u32x4*)p = pack8(o1[0], o1[1]); st16(p + 32, pack8(o2[0], o2[1]));
                } asm volatile("" ::: "memory"); }
    }
};
struct EpiKV {
    static constexpr bool PERM = true;
    bf16_t* KV; const float* SSQKV;
    __device__ __forceinline__ void operator()(const Acc& acc, const Unit& u, int wr, int wc, int fr, int fq) const {
        const int row0 = u.pm * BM + wr * 64 + fr;
#pragma unroll
        for (int ai = 0; ai < 2; ++ai)
#pragma unroll
            for (int m = 0; m < 4; ++m) { const int row = row0 + ai * HALF + m * 16; const float rs = row_rs(SSQKV + (size_t)row * 8, 2, 1.f / KVL);
#pragma unroll
                for (int bj = 0; bj < 2; ++bj) st16(KV + (size_t)row * KVW + u.pn * BM + bj * HALF + wc * 32 + 8 * fq, pack8(acc[ai][bj][m][0] * rs, acc[ai][bj][m][1] * rs)); asm volatile("" ::: "memory"); }
    }
};
struct EpiY {
    static constexpr bool PERM = true;
    const float* mod; bf16_t* Y;
    __device__ __forceinline__ void operator()(const Acc& acc, const Unit& u, int wr, int wc, int fr, int fq) const {
        const int row0 = u.pm * BM + wr * 64 + fr, col0 = u.pn * BM + wc * 32 + 8 * fq; const float* gate = mod + (size_t)((u.pm * BM) / S) * 3 * D + 2 * D;
        f32x4 g[2][2];
#pragma unroll
        for (int bj = 0; bj < 2; ++bj)
#pragma unroll
            for (int n = 0; n < 2; ++n) g[bj][n] = *(const f32x4*)(gate + col0 + bj * HALF + 4 * n) + 1.f;
#pragma unroll
        for (int ai = 0; ai < 2; ++ai)
#pragma unroll
            for (int m = 0; m < 4; ++m)
#pragma unroll
                for (int bj = 0; bj < 2; ++bj) st16(Y + (size_t)(row0 + ai * HALF + m * 16) * D + col0 + bj * HALF, pack8(acc[ai][bj][m][0] * g[bj][0], acc[ai][bj][m][1] * g[bj][1]));
    }
};
struct EpiSwiGLU {
    static constexpr bool PERM = true;
    bf16_t* H; int ldh;
    __device__ __forceinline__ void operator()(const Acc& acc, const Unit& u, int wr, int wc, int fr, int fq) const {
        const int row0 = u.pm * BM + wr * 64 + fr; bf16_t* base = H + u.pn * HALF + wc * 32 + 8 * fq;
#pragma unroll
        for (int ai = 0; ai < 2; ++ai)
#pragma unroll
            for (int m = 0; m < 4; ++m) { f32x4 h0, h1;
#pragma unroll
                for (int e = 0; e < 4; ++e) { h0[e] = silu_f(acc[ai][0][m][0][e]) * acc[ai][1][m][0][e]; h1[e] = silu_f(acc[ai][0][m][1][e]) * acc[ai][1][m][1][e]; }
                st16(base + (size_t)(row0 + ai * HALF + m * 16) * ldh, pack8(h0, h1)); }
    }
};
struct EpiScaleBf16 {
    static constexpr bool PERM = true;
    bf16_t* O; int ldo; const float* scale;
    __device__ __forceinline__ void operator()(const Acc& acc, const Unit& u, int wr, int wc, int fr, int fq) const {
        const int row0 = u.pm * BM + wr * 64 + fr, col0 = u.pn * BM + wc * 32 + 8 * fq;
        f32x4 sc[2][2];
#pragma unroll
        for (int bj = 0; bj < 2; ++bj)
#pragma unroll
            for (int n = 0; n < 2; ++n) sc[bj][n] = *(const f32x4*)(scale + col0 + bj * HALF + 4 * n);
#pragma unroll
        for (int ai = 0; ai < 2; ++ai)
#pragma unroll
            for (int m = 0; m < 4; ++m)
#pragma unroll
                for (int bj = 0; bj < 2; ++bj) st16(O + (size_t)(row0 + ai * HALF + m * 16) * ldo + col0 + bj * HALF, pack8(acc[ai][bj][m][0] * sc[bj][0], acc[ai][bj][m][1] * sc[bj][1]));
    }
};
struct EpiMoeDown {
    static constexpr bool PERM = true;
    bf16_t* YS; const int* ROWTS; const float* ROWW; const unsigned* cnt;
    __device__ __forceinline__ void operator()(const Acc& acc, const Unit& u, int wr, int wc, int fr, int fq) const {
        const int e = u.aux, n = (int)cnt[64 * e], rl0 = (u.pm - e * (CAP / BM)) * BM + wr * 64 + fr, col0 = u.pn * BM + wc * 32 + 8 * fq;
#pragma unroll
        for (int ai = 0; ai < 2; ++ai)
#pragma unroll
            for (int m = 0; m < 4; ++m) { const int rl = rl0 + ai * HALF + m * 16;
                if (rl < n) { const size_t p = (size_t)e * CAP + rl; const int ts = ROWTS[p]; const float w = ROWW[p]; bf16_t* o = YS + (size_t)ts * D + col0;
#pragma unroll
                    for (int bj = 0; bj < 2; ++bj) st16(o + bj * HALF, pack8(acc[ai][bj][m][0] * w, acc[ai][bj][m][1] * w)); } }
    }
};

__device__ __forceinline__ void glds16s(const char* sbase, unsigned voff, unsigned lds_dst) {
    asm volatile("s_mov_b32 m0, %2\n\ts_nop 0\n\tglobal_load_lds_dwordx4 %0, %1" :: "v"(voff), "s"(sbase), "s"(lds_dst) : "memory");
}
template <class Epi, class Sched, bool ALIGN_EPI>
__device__ __forceinline__ void gemm_phase(PG8_LAS unsigned char* lds, const int K, const int lda, const int ldb, const Sched& S, const Epi& E) {
    const int tid = launder((int)threadIdx.x), wid = __builtin_amdgcn_readfirstlane(tid >> 6), lane = tid & 63, wr = wid >> 2, wc = wid & 3, fr = lane & 15, fq = lane >> 4;
    const int nt = K / BK;
    unsigned voffA[2], voffB[2];
#pragma unroll
    for (int i = 0; i < 2; ++i) { int R, C; stage_rc(tid * 16 + i * 8192, R, C); const int Rb = Epi::PERM ? ((R & ~31) + perm32(R & 31)) : R;
        voffA[i] = (unsigned)(R * lda + C) * 2u; voffB[i] = (unsigned)(Rb * ldb + C) * 2u; }
    const size_t kstep = (size_t)(BK * 2);
    const size_t hA = (size_t)HALF * lda * 2, hB = (size_t)HALF * ldb * 2;
    const unsigned ldsbase = (unsigned)(uintptr_t)lds + (unsigned)wid * 1024u;
    const int aoff = lds_byte(wr * 64 + fr, fq * 8), boff = lds_byte(wc * 32 + fr, fq * 8);
#define PG8_SA(b, h) (((b) * 2 + (h)) * HTB)
#define PG8_SB(b, h) ((4 + (b) * 2 + (h)) * HTB)
#define PG8_STAGE(bufoff, gbase, voff) do { _Pragma("unroll") for (int _i = 0; _i < 2; ++_i) \
        glds16s((const char*)(gbase), (voff)[_i], ldsbase + (unsigned)((bufoff) + _i * 8192)); } while (0)
#define PG8_LDA(dst, b, h) do { _Pragma("unroll") for (int m = 0; m < 4; ++m) _Pragma("unroll") for (int k = 0; k < 2; ++k) dst[m][k] = *(const PG8_LAS bf16x8*)(lds + PG8_SA(b, h) + aoff + m * 2048 + k * 1024); } while (0)
#define PG8_LDB(dst, b, h) do { _Pragma("unroll") for (int n = 0; n < 2; ++n) _Pragma("unroll") for (int k = 0; k < 2; ++k) dst[n][k] = *(const PG8_LAS bf16x8*)(lds + PG8_SB(b, h) + boff + n * 2048 + k * 1024); } while (0)
#define PG8_MMA(ai, bj, At, Bt) do { __builtin_amdgcn_s_setprio(1); _Pragma("unroll") for (int m = 0; m < 4; ++m) _Pragma("unroll") for (int n = 0; n < 2; ++n) _Pragma("unroll") for (int k = 0; k < 2; ++k) \
        acc[ai][bj][m][n] = __builtin_amdgcn_mfma_f32_16x16x32_bf16(Bt[n][k], At[m][k], acc[ai][bj][m][n], 0, 0, 0); __builtin_amdgcn_s_setprio(0); } while (0)
#define PG8_WAIT_V(n) asm volatile("s_waitcnt vmcnt(" #n ")" ::: "memory")
#define PG8_WAIT_L(n) asm volatile("s_waitcnt lgkmcnt(" #n ")" ::: "memory")
#define PG8_BAR __builtin_amdgcn_s_barrier()
#define PG8_SCHED __builtin_amdgcn_sched_barrier(0)
    Unit cur, nxt; int ui = 0;
    if (!S.next(0, cur)) return;
    f32x4 acc[2][2][4][2];
#pragma unroll
    for (int a = 0; a < 2; ++a)
#pragma unroll
        for (int b = 0; b < 2; ++b)
#pragma unroll
            for (int m = 0; m < 4; ++m)
#pragma unroll
                for (int n = 0; n < 2; ++n) acc[a][b][m][n] = (f32x4){0.f, 0.f, 0.f, 0.f};
    bf16x8 At[4][2], B0[2][2], B1[2][2];
    const char* cA = cur.A; const char* cB = cur.B;
    PG8_STAGE(PG8_SB(0, 0), cB, voffB); PG8_STAGE(PG8_SB(0, 1), cB + hB, voffB); PG8_STAGE(PG8_SA(0, 0), cA, voffA); PG8_STAGE(PG8_SA(0, 1), cA + hA, voffA);
    if (wr == 1) PG8_BAR;
    PG8_WAIT_V(2); PG8_BAR;
    PG8_STAGE(PG8_SB(1, 0), cB + kstep, voffB); PG8_STAGE(PG8_SA(1, 0), cA + kstep, voffA); PG8_STAGE(PG8_SB(1, 1), cB + hB + kstep, voffB);
    PG8_WAIT_V(6); PG8_BAR;
    for (;;) {
        const bool has_next = S.next(ui + 1, nxt);
        const char* nA = has_next ? nxt.A : cA; const char* nB = has_next ? nxt.B : cB;
        for (int t = 0; t < nt; t += 2) {
            const bool last = (t == nt - 2);
            const char* a1 = cA + (size_t)(t + 1) * kstep;
            const char* a2 = last ? nA : cA + (size_t)(t + 2) * kstep; const char* b2 = last ? nB : cB + (size_t)(t + 2) * kstep;
            const char* a3 = a2 + kstep; const char* b3 = b2 + kstep;
            PG8_LDB(B0, 0, 0); PG8_LDB(B1, 0, 1); PG8_SCHED; PG8_LDA(At, 0, 0); PG8_STAGE(PG8_SA(1, 1), a1 + hA, voffA);
            PG8_WAIT_V(8); PG8_WAIT_L(0); PG8_BAR; PG8_MMA(0, 0, At, B0); PG8_MMA(0, 1, At, B1); PG8_BAR; PG8_SCHED;
            PG8_LDA(At, 0, 1); PG8_STAGE(PG8_SB(0, 0), b2, voffB); PG8_STAGE(PG8_SB(0, 1), b2 + hB, voffB); PG8_STAGE(PG8_SA(0, 0), a2, voffA);
            PG8_WAIT_V(8); PG8_WAIT_L(0); PG8_BAR; PG8_MMA(1, 0, At, B0); PG8_MMA(1, 1, At, B1); PG8_BAR; PG8_SCHED;
            PG8_LDB(B0, 1, 0); PG8_LDB(B1, 1, 1); PG8_SCHED; PG8_LDA(At, 1, 0); PG8_STAGE(PG8_SA(0, 1), a2 + hA, voffA);
            PG8_WAIT_V(8); PG8_WAIT_L(0); PG8_BAR; PG8_MMA(0, 0, At, B0); PG8_MMA(0, 1, At, B1); PG8_BAR; PG8_SCHED;
            PG8_LDA(At, 1, 1); PG8_STAGE(PG8_SB(1, 0), b3, voffB); PG8_STAGE(PG8_SB(1, 1), b3 + hB, voffB); PG8_STAGE(PG8_SA(1, 0), a3, voffA);
            PG8_WAIT_V(8); PG8_WAIT_L(0); PG8_BAR; PG8_MMA(1, 0, At, B0); PG8_MMA(1, 1, At, B1); PG8_BAR; PG8_SCHED;
        }
        if constexpr (ALIGN_EPI) { if (wr == 0) PG8_BAR; }
        E(acc, cur, wr, wc, fr, fq);
        if (!has_next) break;
#pragma unroll
        for (int a = 0; a < 2; ++a)
#pragma unroll
            for (int b = 0; b < 2; ++b)
#pragma unroll
                for (int m = 0; m < 4; ++m)
#pragma unroll
                    for (int n = 0; n < 2; ++n) acc[a][b][m][n] = (f32x4){0.f, 0.f, 0.f, 0.f};
        cur = nxt; cA = nA; cB = nB; ++ui;
        if constexpr (ALIGN_EPI) { if (wr == 1) PG8_BAR; }
    }
    PG8_WAIT_V(0);
    if constexpr (!ALIGN_EPI) { if (wr == 0) PG8_BAR; }
    PG8_BAR;
#undef PG8_SA
#undef PG8_SB
#undef PG8_STAGE
#undef PG8_LDA
#undef PG8_LDB
#undef PG8_MMA
#undef PG8_WAIT_V
#undef PG8_WAIT_L
#undef PG8_BAR
#undef PG8_SCHED
}
}
namespace attn {
using pg8::bf16_t; using pg8::bf16x8; using pg8::u32x4;
typedef short s16x4 __attribute__((ext_vector_type(4)));
typedef float f32x16 __attribute__((ext_vector_type(16)));
constexpr float SCALE = 0.07216878364870322f;
constexpr float C2 = 1.4426950408889634f * SCALE;
constexpr float THR = 8.f;
constexpr int KVBLK = 64, SHM_V = 16384, SHM_KN = 16384, SHM_KR = 8192;
constexpr int NSLOT = 3;
constexpr int OFF_V = 0, OFF_KN = NSLOT * SHM_V, OFF_KR = OFF_KN + NSLOT * SHM_KN, OFF_WS = OFF_KR + NSLOT * SHM_KR, LDS_BYTES = OFF_WS + 8 * 64 * 4;
#define KSWZ(row, colB) ((row) * 256 + ((colB) ^ (((row) & 7) << 4)))
#define SBAR() __builtin_amdgcn_sched_barrier(0)
__device__ __forceinline__ int v_st(int k, int c) { const int kk = (k & ~0xC) | ((k & 4) << 1) | ((k & 8) >> 1); return ((kk >> 3) * 4 + (c >> 5)) * 512 + ((kk & 7) * 32 + (c & 31)) * 2; }
__device__ __forceinline__ int v_rd_base(int lane) { return ((lane & 3) << 3) | (((lane >> 2) & 3) << 6) | (((lane >> 4) & 1) << 5) | (((lane >> 5) & 1) << 8); }
__device__ __forceinline__ int crow(int r, int hi) { return (r & 3) + 8 * (r >> 2) + 4 * hi; }
__device__ __forceinline__ unsigned cvtpk(float lo, float hi) { unsigned r; asm volatile("v_cvt_pk_bf16_f32 %0, %1, %2" : "=v"(r) : "v"(lo), "v"(hi)); return r; }

__device__ __forceinline__ void mask_tile(f32x16& p, int dq) {
    const float NEG = -__builtin_inff();
#pragma unroll
    for (int r = 0; r < 16; ++r) { const int c = (r & 3) + 8 * (r >> 2); if (dq - c < 0) p[r] = NEG; }
}
__device__ __forceinline__ void partialSM(f32x16& p, float& m_reg, float& alpha) {
    float pmax = p[0];
#pragma unroll
    for (int r = 1; r < 16; ++r) pmax = fmaxf(pmax, p[r]);
    { auto rr = __builtin_amdgcn_permlane32_swap(__float_as_uint(pmax), __float_as_uint(pmax), false, false); pmax = fmaxf(__uint_as_float(rr[0]), __uint_as_float(rr[1])); }
    float mn;
    if (__builtin_expect(__all((pmax - m_reg) * SCALE <= THR), 1)) { mn = m_reg; alpha = 1.f; }
    else { mn = fmaxf(m_reg, pmax); alpha = __builtin_amdgcn_exp2f((m_reg - mn) * C2); m_reg = mn; }
    const float mnL = -mn * C2;
#pragma unroll
    for (int r = 0; r < 16; ++r) p[r] = __builtin_amdgcn_exp2f(fmaf(p[r], C2, mnL));
}
__device__ __forceinline__ void finishSM(const f32x16& p, float alpha, float& l_reg, bf16x8& pa0, bf16x8& pa1) {
    float ps = 0.f;
#pragma unroll
    for (int r = 0; r < 16; ++r) ps += p[r];
    { auto rr = __builtin_amdgcn_permlane32_swap(__float_as_uint(ps), __float_as_uint(ps), false, false); ps = __uint_as_float(rr[0]) + __uint_as_float(rr[1]); }
    l_reg = l_reg * alpha + ps;
#define PK4(P, B_, OUT) do { unsigned a0 = cvtpk(P[B_+0], P[B_+1]), a1 = cvtpk(P[B_+2], P[B_+3]); unsigned b0 = cvtpk(P[B_+4], P[B_+5]), b1 = cvtpk(P[B_+6], P[B_+7]); \
        auto r0 = __builtin_amdgcn_permlane32_swap(a0, b0, false, false); auto r1 = __builtin_amdgcn_permlane32_swap(a1, b1, false, false); \
        u32x4 w = {r0[0], r1[0], r0[1], r1[1]}; OUT = *reinterpret_cast<bf16x8*>(&w); } while (0)
    PK4(p, 0, pa0); PK4(p, 8, pa1);
#undef PK4
}
__device__ __forceinline__ void qkt(f32x16& p, const char* KN_lds, const char* KR_lds, int slot, int par, int r32, int hi, const bf16x8* qr) {
    p = f32x16{};
    const char* kb[4];
#pragma unroll
    for (int dd = 0; dd < 4; ++dd) kb[dd] = KN_lds + slot * SHM_KN + par * (32 * 256) + KSWZ(r32, (dd * 16 + hi * 8) * 2);
#pragma unroll
    for (int d0 = 0; d0 < 8; ++d0) { const bf16x8 a = *reinterpret_cast<const bf16x8*>(kb[d0 & 3] + (d0 >> 2) * 128); p = __builtin_amdgcn_mfma_f32_32x32x16_bf16(a, qr[d0], p, 0, 0, 0); }
    const char* rb = KR_lds + slot * SHM_KR + hi * 1024 + (par * 32 + r32) * 16;
#pragma unroll
    for (int d0 = 0; d0 < 4; ++d0) { const bf16x8 a = *reinterpret_cast<const bf16x8*>(rb + d0 * 2048); p = __builtin_amdgcn_mfma_f32_32x32x16_bf16(a, qr[8 + d0], p, 0, 0, 0); }
}
__device__ __forceinline__ void pv_tile(f32x16* o, int vbp, bf16x8 pa0, bf16x8 pa1) {
#define TRRD(dst, off) asm volatile("ds_read_b64_tr_b16 %0, %1 offset:%2" : "=&v"(dst) : "v"(vbp), "i"(off) : "memory")
#define PV_D0(d0) do { s16x4 l0, l1, h0, h1; constexpr int b_ = (d0) * 512; \
        TRRD(l0, b_); TRRD(h0, b_ + 2048); TRRD(l1, b_ + 4096); TRRD(h1, b_ + 6144); \
        asm volatile("s_waitcnt lgkmcnt(0)" ::: "memory"); SBAR(); \
        o[d0] = __builtin_amdgcn_mfma_f32_32x32x16_bf16(pa0, (bf16x8){l0[0], l0[1], l0[2], l0[3], h0[0], h0[1], h0[2], h0[3]}, o[d0], 0, 0, 0); \
        o[d0] = __builtin_amdgcn_mfma_f32_32x32x16_bf16(pa1, (bf16x8){l1[0], l1[1], l1[2], l1[3], h1[0], h1[1], h1[2], h1[3]}, o[d0], 0, 0, 0); } while (0)
    PV_D0(0); PV_D0(1); PV_D0(2); PV_D0(3);
#undef PV_D0
#undef TRRD
}

__device__ __forceinline__ void attn_block(int b, int h, int qb, const bf16_t* __restrict__ Qb, const bf16_t* __restrict__ KVb, const bf16_t* __restrict__ KRb, bf16_t* __restrict__ CAT, char* lds) {
    const int tid = pg8::launder((int)threadIdx.x), wid = __builtin_amdgcn_readfirstlane(tid >> 6), lane = tid & 63, r32 = lane & 31, hi = lane >> 5;
    const int rg = wid & 3, par = wid >> 2;
    const size_t rowbase = (size_t)b * S; const int q0 = qb * 128, NT = 2 * (qb + 1);
    char* V_lds = lds + OFF_V; char* KN_lds = lds + OFF_KN; char* KR_lds = lds + OFF_KR;
    float* ws = (float*)(lds + OFF_WS) + wid * 64; float* li_l = ws; float* al_l = ws + 32;
    const int sr = tid >> 4, sc = (tid & 15) * 8, vst0 = v_st(sr, sc), vst1 = v_st(32 + sr, sc), kws = KSWZ(sr, sc * 2);
    const int krow = tid & 63, kch = tid >> 6, krs = kch * 1024 + krow * 16;
    const char* kvu = (const char*)(KVb + rowbase * KVW + h * 256); const char* ru = (const char*)(KRb + rowbase * 64);
    const unsigned lo_kv = (unsigned)(sr * KVW + sc) * 2u, lo_r = (unsigned)(krow * 64 + kch * 8) * 2u;
    const int vbp = (int)(uintptr_t)V_lds + v_rd_base(lane) + par * 8192;
    bf16x8 st_k0, st_k1, st_v0, st_v1, st_r;
#define SLOAD(k0) do { const char* kb_ = kvu + (size_t)(k0) * (KVW * 2); \
        st_v0 = *(const bf16x8*)(kb_ + 256 + (size_t)lo_kv); st_v1 = *(const bf16x8*)(kb_ + 256 + 32 * KVW * 2 + (size_t)lo_kv); \
        st_k0 = *(const bf16x8*)(kb_ + (size_t)lo_kv); st_k1 = *(const bf16x8*)(kb_ + 32 * KVW * 2 + (size_t)lo_kv); st_r = *(const bf16x8*)(ru + (size_t)(k0) * 128 + (size_t)lo_r); } while (0)
#define SWRITE(bf) do { *(bf16x8*)(V_lds + (bf) * SHM_V + vst0) = st_v0; *(bf16x8*)(V_lds + (bf) * SHM_V + vst1) = st_v1; \
        *(bf16x8*)(KN_lds + (bf) * SHM_KN + kws) = st_k0; *(bf16x8*)(KN_lds + (bf) * SHM_KN + kws + 32 * 256) = st_k1; *(bf16x8*)(KR_lds + (bf) * SHM_KR + krs) = st_r; } while (0)
#define VMW() asm volatile("s_waitcnt vmcnt(0)" ::: "memory")
    SLOAD(0);
    bf16x8 qr[12];
    { const char* qu = (const char*)(Qb + (rowbase + q0 + rg * 32) * QW + h * 192); const unsigned lo_q = (unsigned)(r32 * QW + hi * 8) * 2u;
#pragma unroll
      for (int d0 = 0; d0 < 12; ++d0) qr[d0] = *(const bf16x8*)(qu + d0 * 32 + (size_t)lo_q); }
    float m_reg = -1e30f, l_reg = 0.f; f32x16 o[4] = {};
    const int qrel = q0 + rg * 32;
    const int dq0 = qrel + r32 - 32 * par - 4 * hi;
#define MASKT(P, t) do { const int kb_ = 64 * (t) + 32 * par; if (kb_ + 31 > qrel) mask_tile(P, dq0 - 64 * (t)); } while (0)
#define RESC(a) do { if (__any((a) < 1.f)) { if (hi == 0) al_l[r32] = (a); asm volatile("s_waitcnt lgkmcnt(0)" ::: "memory"); \
        _Pragma("unroll") for (int d_ = 0; d_ < 4; ++d_) _Pragma("unroll") for (int r = 0; r < 16; ++r) o[d_][r] *= al_l[crow(r, hi)]; } } while (0)
    f32x16 pA, pB; float alA, alB; bf16x8 pa0, pa1;
    VMW(); SWRITE(0);
    __syncthreads();
    SLOAD(64);
    SBAR(); qkt(pA, KN_lds, KR_lds, 0, par, r32, hi, qr);
    MASKT(pA, 0); partialSM(pA, m_reg, alA);
    VMW(); SWRITE(1); if (NT > 2) SLOAD(128);
    __syncthreads();
    int s_prev = 0, s_cur = 1, s_next = 2;
#define HALF_STEP(PX, alX, PY, alY, t) do { \
        SBAR(); qkt(PX, KN_lds, KR_lds, s_cur, par, r32, hi, qr); \
        finishSM(PY, alY, l_reg, pa0, pa1); SBAR(); \
        pv_tile(o, vbp + s_prev * SHM_V, pa0, pa1); MASKT(PX, (t)); partialSM(PX, m_reg, alX); \
        if ((t) + 1 < NT) { VMW(); SWRITE(s_next); SBAR(); if ((t) + 2 < NT) SLOAD(((t) + 2) * 64); } \
        RESC(alX); __syncthreads(); \
        s_prev = s_cur; s_cur = s_next; s_next = (s_next == NSLOT - 1) ? 0 : s_next + 1; } while (0)
    for (int t = 1; t + 1 < NT; t += 2) {
        HALF_STEP(pB, alB, pA, alA, t);
        HALF_STEP(pA, alA, pB, alB, t + 1);
    }
    SBAR(); qkt(pB, KN_lds, KR_lds, s_cur, par, r32, hi, qr); SBAR();
    finishSM(pA, alA, l_reg, pa0, pa1); SBAR();
    pv_tile(o, vbp + s_prev * SHM_V, pa0, pa1);
    MASKT(pB, NT - 1); partialSM(pB, m_reg, alB); RESC(alB);
    finishSM(pB, alB, l_reg, pa0, pa1); SBAR(); pv_tile(o, vbp + s_cur * SHM_V, pa0, pa1);
    __syncthreads();
    float* mo = (float*)lds; float* ml = (float*)(lds + 65536);
    if (par == 1) {
#pragma unroll
        for (int d0 = 0; d0 < 4; ++d0)
#pragma unroll
            for (int r = 0; r < 16; ++r) mo[(rg * 64 + d0 * 16 + r) * 64 + lane] = o[d0][r];
        if (hi == 0) { ml[rg * 64 + r32] = m_reg; ml[rg * 64 + 32 + r32] = l_reg; }
    }
    __syncthreads();
    if (par == 0) {
        const float m1 = ml[rg * 64 + r32], l1 = ml[rg * 64 + 32 + r32];
        const float m = fmaxf(m_reg, m1), a0 = __builtin_amdgcn_exp2f((m_reg - m) * C2), a1 = __builtin_amdgcn_exp2f((m1 - m) * C2);
        const float linv = 1.f / (l_reg * a0 + l1 * a1);
        if (hi == 0) { li_l[r32] = a0 * linv; al_l[r32] = a1 * linv; }
        asm volatile("s_waitcnt lgkmcnt(0)" ::: "memory");
        char* ou = (char*)(CAT + (rowbase + q0 + rg * 32) * 2048 + h * 128); const unsigned lo_o = (unsigned)(4 * hi * 2048 + r32) * 2u;
#pragma unroll
        for (int r = 0; r < 16; ++r) { const int orow = crow(r, hi); const float f0 = li_l[orow], f1 = al_l[orow];
#pragma unroll
            for (int d0 = 0; d0 < 4; ++d0) { const float v = o[d0][r] * f0 + mo[(rg * 64 + d0 * 16 + r) * 64 + lane] * f1; const float vn = __shfl_xor(v, 1);
                if ((r32 & 1) == 0) *(unsigned*)(ou + (((r & 3) + 8 * (r >> 2)) * 4096 + d0 * 64) + (size_t)lo_o) = cvtpk(v, vn); }
            asm volatile("" ::: "memory"); }
    }
    __syncthreads();
#undef SLOAD
#undef SWRITE
#undef VMW
#undef MASKT
#undef RESC
#undef HALF_STEP
}
#undef KSWZ
#undef SBAR
}

namespace sgu {
using pg8::bf16_t; using pg8::bf16x8; using pg8::f32x4; using pg8::u32x4; using pg8::u32x2;
constexpr int VT_PITCH = 272;
constexpr int LDS_BYTES = 128 * VT_PITCH;
__device__ __forceinline__ float bf2f(unsigned short v) { return __uint_as_float((unsigned)v << 16); }
__device__ __forceinline__ void sgu_unit(int n, int g, const bf16_t* __restrict__ ZU, const bf16_t* __restrict__ ZV, const float* __restrict__ ng, const float* __restrict__ nb,
                                         const float* __restrict__ W, const float* __restrict__ bs, bf16_t* __restrict__ CAT, char* lds) {
    const int tid = pg8::launder((int)threadIdx.x), wid = __builtin_amdgcn_readfirstlane(tid >> 6), lane = tid & 63, fr = lane & 15, fq = lane >> 4;
    const size_t t0 = (size_t)n * CH;
    const int row = tid >> 2, q = tid & 3; const char* src = (const char*)(ZV + t0 * SGW + g * GD) + (size_t)((unsigned)(row * SGW + q * 32) * 2u);
    u32x4 zw[4];
#pragma unroll
    for (int i = 0; i < 4; ++i) zw[i] = *(const u32x4*)(src + 16 * i);
    const int tl = wid * 16 + fr;
    const float* wrow = (const float*)((const char*)(W + (size_t)g * CH * CH) + (size_t)((unsigned)(tl * CH + 8 * fq) * 4u));
    f32x4 wraw[4][2];
#pragma unroll
    for (int ks = 0; ks < 4; ++ks) { if (ks * 32 <= wid * 16 + 15) { wraw[ks][0] = *(const f32x4*)(wrow + ks * 32); wraw[ks][1] = *(const f32x4*)(wrow + ks * 32 + 4); } else { wraw[ks][0] = (f32x4){0.f, 0.f, 0.f, 0.f}; wraw[ks][1] = wraw[ks][0]; } }
    const bf16_t* up = (const bf16_t*)((const char*)(ZU + t0 * SGW + g * GD) + (size_t)((unsigned)(tl * SGW + 4 * fq) * 2u)); bf16_t* op = (bf16_t*)((char*)(CAT + t0 * 2048 + 1024 + g * GD) + (size_t)((unsigned)(tl * 2048 + 4 * fq) * 2u));
    u32x2 uw[8];
#pragma unroll
    for (int cb = 0; cb < 8; ++cb) uw[cb] = *(const u32x2*)(up + cb * 16);
    const float bias = bs[g * CH + tl];
    asm volatile("" ::: "memory");
    {
        float v[32];
#pragma unroll
        for (int i = 0; i < 4; ++i) { const u32x4 w = zw[i];
#pragma unroll
            for (int e = 0; e < 4; ++e) { v[8 * i + 2 * e] = __uint_as_float(w[e] << 16); v[8 * i + 2 * e + 1] = __uint_as_float(w[e] & 0xffff0000u); } }
        float s = 0.f;
#pragma unroll
        for (int i = 0; i < 32; ++i) s += v[i];
        s += __shfl_xor(s, 1); s += __shfl_xor(s, 2);
        const float mu = s * (1.f / GD); float qq = 0.f;
#pragma unroll
        for (int i = 0; i < 32; ++i) { v[i] -= mu; qq += v[i] * v[i]; }
        qq += __shfl_xor(qq, 1); qq += __shfl_xor(qq, 2);
        const float rstd = 1.f / sqrtf(qq * (1.f / GD) + LN_EPS);
        const float* gp = (const float*)((const char*)(ng + g * GD) + (size_t)((unsigned)q * 128u)); const float* bp = (const float*)((const char*)(nb + g * GD) + (size_t)((unsigned)q * 128u));
#pragma unroll
        for (int i4 = 0; i4 < 32; i4 += 4) { const f32x4 g4 = *(const f32x4*)(gp + i4), b4 = *(const f32x4*)(bp + i4);
#pragma unroll
            for (int e = 0; e < 4; e += 2) { const int i = i4 + e; const unsigned pk = pg8::cvt_pk_bf16(v[i] * rstd * g4[e] + b4[e], v[i + 1] * rstd * g4[e + 1] + b4[e + 1]);
                *(unsigned short*)(lds + (q * 32 + i) * VT_PITCH + row * 2) = (unsigned short)(pk & 0xffffu); *(unsigned short*)(lds + (q * 32 + i + 1) * VT_PITCH + row * 2) = (unsigned short)(pk >> 16); }
            asm volatile("" ::: "memory"); }
    }
    __syncthreads();
    f32x4 acc[8];
#pragma unroll
    for (int cb = 0; cb < 8; ++cb) acc[cb] = (f32x4){0.f, 0.f, 0.f, 0.f};
#pragma unroll
    for (int ks = 0; ks < 4; ++ks) {
        if (ks * 32 <= wid * 16 + 15) {
            const int s0 = ks * 32 + 8 * fq; const f32x4 w0 = wraw[ks][0], w1 = wraw[ks][1];
            float wv[8] = {w0[0], w0[1], w0[2], w0[3], w1[0], w1[1], w1[2], w1[3]};
#pragma unroll
            for (int e = 0; e < 8; ++e) wv[e] = (s0 + e <= tl) ? wv[e] : 0.f;
            u32x4 wp; wp.x = pg8::cvt_pk_bf16(wv[0], wv[1]); wp.y = pg8::cvt_pk_bf16(wv[2], wv[3]); wp.z = pg8::cvt_pk_bf16(wv[4], wv[5]); wp.w = pg8::cvt_pk_bf16(wv[6], wv[7]);
            const bf16x8 bfrag = *reinterpret_cast<const bf16x8*>(&wp);
#pragma unroll
            for (int cb = 0; cb < 8; ++cb) { const bf16x8 afrag = *(const bf16x8*)(lds + (cb * 16 + fr) * VT_PITCH + s0 * 2);
                acc[cb] = __builtin_amdgcn_mfma_f32_16x16x32_bf16(afrag, bfrag, acc[cb], 0, 0, 0); }
        }
    }
#pragma unroll
    for (int cb = 0; cb < 8; ++cb) { const u32x2 uwv = uw[cb];
        const float u0 = __uint_as_float(uwv.x << 16), u1 = __uint_as_float(uwv.x & 0xffff0000u), u2 = __uint_as_float(uwv.y << 16), u3 = __uint_as_float(uwv.y & 0xffff0000u);
        u32x2 ow; ow.x = pg8::cvt_pk_bf16(u0 * (acc[cb][0] + bias), u1 * (acc[cb][1] + bias)); ow.y = pg8::cvt_pk_bf16(u2 * (acc[cb][2] + bias), u3 * (acc[cb][3] + bias));
        *(u32x2*)(op + cb * 16) = ow; }
    __syncthreads();
}
}
#define GAS __attribute__((address_space(1)))
#define LAS __attribute__((address_space(3)))
typedef unsigned short bf16;
typedef unsigned v4u __attribute__((ext_vector_type(4)));
typedef unsigned v2u __attribute__((ext_vector_type(2)));
typedef float f32x4 __attribute__((ext_vector_type(4)));
typedef GAS unsigned gu32;
#define RLX_AGENT __ATOMIC_RELAXED, __HIP_MEMORY_SCOPE_AGENT
#define LDS_WAIT() asm volatile("s_waitcnt lgkmcnt(0)" ::: "memory")
#define VM_WAIT() asm volatile("s_waitcnt vmcnt(0)" ::: "memory")

constexpr int NWAVES = 8;
constexpr size_t MiB = 1u << 20;
constexpr size_t WS_CTL = 0, CTL_ZERO_BYTES = 1 * MiB;
constexpr size_t WS_MOD = 1 * MiB, WS_COS = 2 * MiB, WS_SIN = 3 * MiB, WS_SSQQ = 4 * MiB, WS_SSQKV = 5 * MiB, WS_KRAW = 6 * MiB, WS_KRB = 8 * MiB, WS_ROWTS = 9 * MiB, WS_ROWW = 10 * MiB;
constexpr size_t WS_X = 16 * MiB, WS_VB = 80 * MiB, WS_HMB = 144 * MiB, WS_WE = 176 * MiB, WS_WO = 276 * MiB, WS_ACT = 564 * MiB, WS_END = 1364 * MiB;
constexpr size_t WS_CQ = WS_ACT, WS_CKV = WS_CQ + 12 * MiB, WS_ZU = WS_CKV + 8 * MiB, WS_ZV = WS_ZU + 16 * MiB, WS_QB = WS_ZV + 16 * MiB, WS_KVB = WS_QB + 24 * MiB, WS_CAT = WS_KVB + 32 * MiB, WS_H = WS_CAT + 32 * MiB;
static_assert(WS_H + (size_t)T * FF * 2 <= WS_END, "even map");
constexpr size_t WS_PD = WS_ACT, WS_PP = WS_PD + 32 * MiB, WS_HMS = WS_PP + 32 * MiB, WS_HS = WS_HMS + (size_t)NE * CAP * D * 2, WS_YS = WS_HS + (size_t)NE * CAP * FE * 2;
static_assert(WS_YS + (size_t)2 * T * D * 4 <= WS_END, "odd map");
constexpr size_t WE_IN = 0, WE_Q = WE_IN + (size_t)INWP * D, WE_KV = WE_Q + (size_t)QW * QL, WE_OUT = WE_KV + (size_t)KVW * KVL, WE_GU = WE_OUT + (size_t)D * D, WE_DN = WE_GU + (size_t)2 * FF * D, WE_END = WE_DN + (size_t)D * FF;
constexpr size_t WO_POOL = 0, WO_OC = WO_POOL + (size_t)D * 512, WO_GU = WO_OC + (size_t)D * D, WO_DN = WO_GU + (size_t)NE * 2 * FE * D, WO_END = WO_DN + (size_t)NE * D * FE;
static_assert(WE_END * 2 <= 100 * MiB && WO_END * 2 <= 288 * MiB, "weight regions");
constexpr int CW_BAR = 4096;
constexpr int CW_MOECNT = 16384;
constexpr int RING_BYTES = 131072, LDSCTL_OFF = RING_BYTES, MISC_OFF = LDSCTL_OFF + 320, LDS_BYTES = 147456;

__device__ __forceinline__ unsigned pk2(float lo, float hi) { return pg8::cvt_pk_bf16(lo, hi); }

#define XB_TMO      128
#define XB_XCNT(j)  (256  + 64 * (j))
#define XB_XSUB(j)  (1280 + 64 * (j))
#define XB_XGEN(j)  (2304 + 64 * (j))
#define XB_TOP      3328
#define XB_TOPGEN   3392
#define XCD_BAR_WORDS 3456
#define XB_SPIN_CAP (1u << 18)
__device__ __forceinline__ unsigned xb_ld(unsigned* p)              { return __hip_atomic_load(p, __ATOMIC_RELAXED, __HIP_MEMORY_SCOPE_AGENT); }
__device__ __forceinline__ unsigned xb_add(unsigned* p, unsigned v) { return __hip_atomic_fetch_add(p, v, __ATOMIC_RELAXED, __HIP_MEMORY_SCOPE_AGENT); }
__device__ __forceinline__ unsigned xb_xcc_id() { return (unsigned)__builtin_amdgcn_s_getreg((3 << 11) | 20) & 0xFu; }
#define XB_SPIN(cond, bar) do { unsigned _sp = 0; while (cond) { __builtin_amdgcn_s_sleep(1); \
    if ((++_sp & 255u) == 0u) { if (xb_ld(&(bar)[XB_TMO])) break; if (_sp > XB_SPIN_CAP) { atomicAdd(&(bar)[XB_TMO], 1u); break; } } } } while (0)
struct XcdBarrier { unsigned* bar; unsigned x; volatile LAS unsigned* st; };
__device__ __forceinline__ XcdBarrier xcd_barrier_post(unsigned* bar, volatile LAS unsigned* st) {
    XcdBarrier b; b.bar = bar; b.x = xb_xcc_id(); b.st = st;
    if (threadIdx.x == 0) (void)xb_add(&bar[XB_XCNT(b.x)], 1u);
    return b;
}
__device__ __forceinline__ void xcd_barrier_complete(unsigned* bar, unsigned x, unsigned& nloc, unsigned& nx) {
    const unsigned G = gridDim.x * gridDim.y * gridDim.z;
    unsigned sum, cnt, mine, sp = 0u;
    for (;;) {
        sum = 0u; cnt = 0u; mine = 0u;
#pragma unroll
        for (unsigned j = 0; j < 16; ++j) { const unsigned c = xb_ld(&bar[XB_XCNT(j)]); sum += c; cnt += (c > 0u) ? 1u : 0u; mine = (j == x) ? c : mine; }
        if (sum == G) break;
        __builtin_amdgcn_s_sleep(1);
        if ((++sp & 255u) == 0u) { if (xb_ld(&bar[XB_TMO])) break; if (sp > XB_SPIN_CAP) { atomicAdd(&bar[XB_TMO], 1u); break; } }
    }
    nloc = mine > 0u ? mine : 1u; nx = cnt > 0u ? cnt : 1u;
}
__device__ __forceinline__ void xcd_barrier(const XcdBarrier& b) {
    asm volatile("s_waitcnt vmcnt(0)" ::: "memory");
    __syncthreads();
    if (threadIdx.x == 0) {
        unsigned* bar = b.bar;
        __builtin_amdgcn_s_waitcnt(0);
        unsigned nloc = b.st[0], nx = b.st[1];
        if (nloc == 0u) { xcd_barrier_complete(bar, b.x, nloc, nx); b.st[0] = nloc; b.st[1] = nx; }
        const unsigned old = xb_add(&bar[XB_XSUB(b.x)], 1u);
        const unsigned gen = old / nloc;
        if (old + 1u == (gen + 1u) * nloc) {
            __builtin_amdgcn_fence(__ATOMIC_RELEASE, "agent");
            asm volatile("s_waitcnt vmcnt(0)" ::: "memory");
            const unsigned og = xb_add(&bar[XB_TOP], 1u);
            const unsigned tg = og / nx;
            if (og + 1u == (tg + 1u) * nx) xb_add(&bar[XB_TOPGEN], 1u);
            else XB_SPIN(xb_ld(&bar[XB_TOPGEN]) == tg, bar);
            __builtin_amdgcn_fence(__ATOMIC_ACQUIRE, "agent");
            xb_add(&bar[XB_XGEN(b.x)], 1u);
            asm volatile("s_waitcnt vmcnt(0)" ::: "memory");
        } else {
            XB_SPIN(xb_ld(&bar[XB_XGEN(b.x)]) == gen, bar);
            __builtin_amdgcn_fence(__ATOMIC_ACQUIRE, "agent");
            asm volatile("s_waitcnt vmcnt(0)" ::: "memory");
        }
    }
    __syncthreads();
}

struct Frame {
    LAS unsigned char* lds; volatile LAS unsigned* MISC; gu32* ctl; unsigned char* ws;
    int tid, lane, wave, vcu, G, gw, NGW;
    const float* const* in; float* out;
};
__device__ __forceinline__ float wave_sum(float v) {
#pragma unroll
    for (int o = 1; o < 64; o <<= 1) v += __shfl_xor(v, o);
    return v;
}
__device__ __forceinline__ void conv_item(const float* W, int N, bf16* WT, int ldk, int dst_row0, const float* kscale, LAS float* scr, int k0, int n0, int lane) {
    const int row = lane >> 3, c4 = lane & 7; const float* src = W + (size_t)(k0 + row) * N + n0 + 4 * c4;
    f32x4 v[8];
#pragma unroll
    for (int i = 0; i < 8; ++i) v[i] = *(const GAS f32x4*)(src + (size_t)(8 * i) * N);
    if (kscale) {
#pragma unroll
        for (int i = 0; i < 8; ++i) v[i] = v[i] * kscale[k0 + row + 8 * i]; }
#pragma unroll
    for (int i = 0; i < 8; ++i) { LAS float* d = scr + (row + 8 * i) * 33 + 4 * c4; d[0] = v[i][0]; d[1] = v[i][1]; d[2] = v[i][2]; d[3] = v[i][3]; }
    LDS_WAIT(); asm volatile("" ::: "memory");
    const int nl = lane & 7, c = lane >> 3;
#pragma unroll
    for (int j = 0; j < 4; ++j) { const int n = nl + 8 * j; const LAS float* s = scr + (8 * c) * 33 + n;
        v4u o; o.x = pk2(s[0 * 33], s[1 * 33]); o.y = pk2(s[2 * 33], s[3 * 33]); o.z = pk2(s[4 * 33], s[5 * 33]); o.w = pk2(s[6 * 33], s[7 * 33]);
        *(GAS v4u*)(WT + (size_t)(dst_row0 + n) * ldk + k0 + 8 * c) = o; }
    LDS_WAIT(); asm volatile("" ::: "memory");
}
template <class RowMap>
__device__ __forceinline__ bool conv_mat(int& it, const float* W, int K, int N, bf16* WT, const float* kscale, LAS float* scr, int lane, RowMap rm) {
    const int nblk = N / 32, cnt = (K / 64) * nblk; if (it >= cnt) { it -= cnt; return false; }
    const int kb = it / nblk, nb = it % nblk; conv_item(W, N, WT, K, rm(nb * 32), kscale, scr, kb * 64, nb * 32, lane); return true;
}
struct RmId { int off; __device__ int operator()(int n0) const { return off + n0; } };
struct RmIn { __device__ int operator()(int n0) const { return n0 < 1280 ? n0 : (n0 < 1344 ? 3328 + (n0 - 1280) : n0 - 64); } };
struct RmQ { __device__ int operator()(int n0) const { const int head = n0 / 192, w = n0 % 192; return w < 128 ? (head >> 1) * 256 + (head & 1) * 128 + w : 1024 + (head >> 2) * 256 + ((w - 128) >> 5) * 128 + (head & 3) * 32; } };
struct RmGU { int up; __device__ int operator()(int n0) const { return (n0 >> 7) * 256 + up * 128 + (n0 & 127); } };

constexpr int NIT_EVEN = (D / 64) * (INW / 32) + (QL / 64) * (QW / 32) + (KVL / 64) * (KVW / 32) + (D / 64) * (D / 32) + 2 * (D / 64) * (FF / 32) + (FF / 64) * (D / 32);
constexpr int NIT_ODD = 4 * (512 / 64) * (512 / 32) + (D / 64) * (D / 32) + NE * (2 * (D / 64) * (FE / 32) + (FE / 64) * (D / 32));
__device__ __forceinline__ void convert_even(Frame& F, int j, int lo, int hi, int w0, int nw) {
    const int ln_ = pg8::launder(F.lane);
    LAS float* scr = (LAS float*)(F.lds + F.wave * 16384); bf16* Wb = (bf16*)(F.ws + WS_WE);
    for (int it0 = lo + w0; it0 < hi; it0 += nw) { int it = it0;
        if (conv_mat(it, F.in[7] + (size_t)j * D * INW, D, INW, Wb + WE_IN, nullptr, scr, ln_, RmIn{})) continue;
        if (conv_mat(it, F.in[9] + (size_t)j * QL * QW, QL, QW, Wb + WE_Q, F.in[8] + j * QL, scr, ln_, RmQ{})) continue;
        if (conv_mat(it, F.in[11] + (size_t)j * KVL * KVW, KVL, KVW, Wb + WE_KV, F.in[10] + j * KVL, scr, ln_, RmId{0})) continue;
        if (conv_mat(it, F.in[16] + (size_t)j * D * D, D, D, Wb + WE_OUT, nullptr, scr, ln_, RmId{0})) continue;
        if (conv_mat(it, F.in[17] + (size_t)j * D * FF, D, FF, Wb + WE_GU, nullptr, scr, ln_, RmGU{0})) continue;
        if (conv_mat(it, F.in[18] + (size_t)j * D * FF, D, FF, Wb + WE_GU, nullptr, scr, ln_, RmGU{1})) continue;
        conv_mat(it, F.in[19] + (size_t)j * FF * D, FF, D, Wb + WE_DN, nullptr, scr, ln_, RmId{0});
    }
}
__device__ __forceinline__ void convert_odd(Frame& F, int j, int lo, int hi, int w0, int nw) {
    const int ln_ = pg8::launder(F.lane);
    LAS float* scr = (LAS float*)(F.lds + F.wave * 16384); bf16* Wb = (bf16*)(F.ws + WS_WO);
    constexpr int NPOOL = (512 / 64) * (512 / 32), NOC = (D / 64) * (D / 32), NGU = (D / 64) * (FE / 32), NDN = (FE / 64) * (D / 32), NEXP = 2 * NGU + NDN;
    static_assert(NIT_ODD == 4 * NPOOL + NOC + NE * NEXP, "item count");
    for (int it0 = lo + w0; it0 < hi; it0 += nw) { int it = it0;
        if (it < 4 * NPOOL) { const int gi = it / NPOOL; it -= gi * NPOOL; conv_mat(it, F.in[20] + ((size_t)j * 4 + gi) * 512 * 512, 512, 512, Wb + WO_POOL, nullptr, scr, ln_, RmId{gi * 512}); continue; }
        it -= 4 * NPOOL;
        if (conv_mat(it, F.in[22] + (size_t)j * D * D, D, D, Wb + WO_OC, nullptr, scr, ln_, RmId{0})) continue;
        const int e = it / NEXP; it -= e * NEXP; const size_t eo = (size_t)j * NE + e;
        if (conv_mat(it, F.in[24] + eo * D * FE, D, FE, Wb + WO_GU + (size_t)e * 2 * FE * D, nullptr, scr, ln_, RmGU{0})) continue;
        if (conv_mat(it, F.in[25] + eo * D * FE, D, FE, Wb + WO_GU + (size_t)e * 2 * FE * D, nullptr, scr, ln_, RmGU{1})) continue;
        conv_mat(it, F.in[26] + eo * FE * D, FE, D, Wb + WO_DN + (size_t)e * D * FE, nullptr, scr, ln_, RmId{0});
    }
}
__device__ __forceinline__ void ada_phase(Frame& F) {
    const int ln_ = pg8::launder(F.lane);
    const float* c = F.in[1]; const float* aw = F.in[3]; const float* ab = F.in[4]; float* MOD = (float*)(F.ws + WS_MOD);
    LAS float* red = (LAS float*)(F.lds);
    LAS float* sc = (LAS float*)(F.lds + 8192);
    for (int i = F.tid; i < 2 * D; i += NWAVES * 64) sc[i] = pg8::silu_f(c[i]);
    __syncthreads();
    for (int u = F.vcu; u < 8 * 96; u += F.G) {
        const int ls = u / 96, n = (u % 96) * 64 + ln_; const float* wp = aw + ((size_t)ls * D + F.wave * 256) * 3 * D + n;
        const LAS float* s0 = sc + F.wave * 256; const LAS float* s1 = sc + D + F.wave * 256;
        float a0 = 0.f, a1 = 0.f;
#pragma unroll 32
        for (int k = 0; k < 256; ++k) { const float wv = wp[(size_t)k * 3 * D]; a0 += s0[k] * wv; a1 += s1[k] * wv; }
        red[(F.wave * 2 + 0) * 64 + ln_] = a0; red[(F.wave * 2 + 1) * 64 + ln_] = a1;
        __syncthreads();
        if (F.wave < 2) { float s = 0.f;
#pragma unroll
            for (int w = 0; w < 8; ++w) s += red[(w * 2 + F.wave) * 64 + ln_];
            MOD[((size_t)ls * 2 + F.wave) * 3 * D + n] = s + ab[(size_t)ls * 3 * D + n]; }
        __syncthreads();
    }
}
__device__ const double ROPE_INV[32] = {1.0, 0.7498942093324559, 0.5623413251903491, 0.4216965034285822, 0.31622776601683794, 0.23713737056616552, 0.1778279410038923, 0.1333521432163324, 0.1, 0.07498942093324558, 0.05623413251903491, 0.042169650342858224, 0.03162277660168379, 0.023713737056616554, 0.01778279410038923, 0.01333521432163324, 0.01, 0.007498942093324558, 0.005623413251903491, 0.004216965034285823, 0.0031622776601683794, 0.0023713737056616554, 0.0017782794100389228, 0.001333521432163324, 0.001, 0.0007498942093324559, 0.0005623413251903491, 0.00042169650342858224, 0.00031622776601683794, 0.00023713737056616554, 0.00017782794100389227, 0.0001333521432163324};
__device__ __forceinline__ void rope_tab_phase(Frame& F) {
    const int* pos = (const int*)F.in[2]; float* cs = (float*)(F.ws + WS_COS); float* sn = (float*)(F.ws + WS_SIN);
    for (int i = F.vcu * 512 + pg8::launder(F.tid); i < T * 32; i += F.G * 512) {
        const int t = i >> 5, f = i & 31;
        const double ang = (double)pos[t] * ROPE_INV[f];
        const double kq = __builtin_rint(ang * 0.6366197723675814); const double r = ang - kq * 1.5707963267948966; const double r2 = r * r;
        const double sr = r * (1.0 + r2 * (-1.0 / 6 + r2 * (1.0 / 120 + r2 * (-1.0 / 5040 + r2 * (1.0 / 362880 + r2 * (-1.0 / 39916800 + r2 * (1.0 / 6227020800.0)))))));
        const double cr = 1.0 + r2 * (-0.5 + r2 * (1.0 / 24 + r2 * (-1.0 / 720 + r2 * (1.0 / 40320 + r2 * (-1.0 / 3628800 + r2 * (1.0 / 479001600.0))))));
        const int q = ((int)kq) & 3;
        const double s = (q == 0) ? sr : (q == 1) ? cr : (q == 2) ? -sr : -cr;
        const double cc = (q == 0) ? cr : (q == 1) ? -sr : (q == 2) ? -cr : sr;
        cs[i] = (float)cc; sn[i] = (float)s;
    }
}
template <int MODE, int NEXT>
__device__ __forceinline__ void ln_phase(Frame& F, const float* vsrc, const float* xres, const float* modcur, const float* ys, const float* lg, const float* lb, float* xout,
                                         const float* modnext, bf16* hmb, const float* rw, gu32* cnt, const bool do_hm) {
    const int ln_ = pg8::launder(F.lane);
    if (NEXT == 2) {
        for (int i = pg8::launder(F.tid); i < D * NE / 4; i += NWAVES * 64) { const f32x4 r = *(const GAS f32x4*)(rw + 4 * (size_t)i); const int col = i >> 1, e0 = (i & 1) * 4;
#pragma unroll
            for (int k = 0; k < 4; ++k) *(LAS float*)(F.lds + ((size_t)(e0 + k) * D + col) * 4) = r[k]; }
        __syncthreads();
    }
    f32x4 xr[8]; v2u yr[8], cr[8];
#define LN_LOAD(r_) do { _Pragma("unroll") for (int j = 0; j < 8; ++j) { const int col = 256 * j + 4 * ln_; xr[j] = *(const GAS f32x4*)(xres + (size_t)(r_) * D + col); \
        if (MODE == 0) yr[j] = *(const GAS v2u*)((const bf16*)vsrc + (size_t)(r_) * D + col); \
        else { yr[j] = *(const GAS v2u*)((const bf16*)ys + (size_t)(2 * (r_)) * D + col); cr[j] = *(const GAS v2u*)((const bf16*)ys + (size_t)(2 * (r_) + 1) * D + col); } } } while (0)
    if (F.gw < T) LN_LOAD(F.gw);
    for (int row = F.gw; row < T; row += F.NGW) {
        const int b = row / S; f32x4 v[8];
        if (MODE == 0) {
#pragma unroll
            for (int j = 0; j < 8; ++j) { const v2u y = yr[j];
                v[j] = xr[j] * ALPHA + (f32x4){__uint_as_float(y.x << 16), __uint_as_float(y.x & 0xffff0000u), __uint_as_float(y.y << 16), __uint_as_float(y.y & 0xffff0000u)}; }
        } else {
            const float* gate = modcur + (size_t)b * 3 * D + 2 * D;
#pragma unroll
            for (int j = 0; j < 8; ++j) { const int col = 256 * j + 4 * ln_; const f32x4 g = *(const GAS f32x4*)(gate + col); const v2u a = yr[j], c = cr[j];
                const f32x4 y = (f32x4){__uint_as_float(a.x << 16) + __uint_as_float(c.x << 16), __uint_as_float(a.x & 0xffff0000u) + __uint_as_float(c.x & 0xffff0000u),
                                        __uint_as_float(a.y << 16) + __uint_as_float(c.y << 16), __uint_as_float(a.y & 0xffff0000u) + __uint_as_float(c.y & 0xffff0000u)};
                v[j] = xr[j] * ALPHA + (g + 1.f) * y; }
        }
        if (row + F.NGW < T) LN_LOAD(row + F.NGW);
        float s = 0.f;
#pragma unroll
        for (int j = 0; j < 8; ++j) s += (v[j][0] + v[j][1]) + (v[j][2] + v[j][3]);
        const float mean = wave_sum(s) * (1.f / D); float s2 = 0.f;
#pragma unroll
        for (int j = 0; j < 8; ++j) { v[j] = v[j] - mean; s2 += (v[j][0] * v[j][0] + v[j][1] * v[j][1]) + (v[j][2] * v[j][2] + v[j][3] * v[j][3]); }
        const float rstd = 1.f / sqrtf(wave_sum(s2) * (1.f / D) + LN_EPS);
#pragma unroll
        for (int j = 0; j < 8; ++j) { const int col = 256 * j + 4 * ln_; v[j] = v[j] * rstd * *(const GAS f32x4*)(lg + col) + *(const GAS f32x4*)(lb + col);
            *(GAS f32x4*)(xout + (size_t)row * D + col) = v[j]; }
        if (NEXT != 0 && do_hm) {
            const float* mn = modnext + (size_t)b * 3 * D;
#pragma unroll
            for (int j = 0; j < 8; ++j) { const int col = 256 * j + 4 * ln_; v[j] = v[j] * (*(const GAS f32x4*)(mn + D + col) + 1.f) + *(const GAS f32x4*)(mn + col); }
            if (NEXT == 1) {
#pragma unroll
                for (int j = 0; j < 8; ++j) { v2u o; o.x = pk2(v[j][0], v[j][1]); o.y = pk2(v[j][2], v[j][3]); *(GAS v2u*)(hmb + (size_t)row * D + 256 * j + 4 * ln_) = o; }
            } else {
                float lgt[NE];
#pragma unroll
                for (int e = 0; e < NE; ++e) lgt[e] = 0.f;
#pragma unroll
                for (int e = 0; e < NE; ++e) {
#pragma unroll
                    for (int j = 0; j < 8; ++j) { const f32x4 r = *(const LAS f32x4*)(F.lds + ((size_t)e * D + 256 * j + 4 * ln_) * 4); lgt[e] += (v[j][0] * r[0] + v[j][1] * r[1]) + (v[j][2] * r[2] + v[j][3] * r[3]); }
                    if (e & 1) asm volatile("" ::: "memory"); }
#pragma unroll
                for (int e = 0; e < NE; ++e) lgt[e] = wave_sum(lgt[e]);
                int i1 = 0; float v1 = lgt[0];
#pragma unroll
                for (int e = 1; e < NE; ++e) if (lgt[e] > v1) { v1 = lgt[e]; i1 = e; }
                int i2 = 0; float v2 = -3.4e38f;
#pragma unroll
                for (int e = 0; e < NE; ++e) if (e != i1 && lgt[e] > v2) { v2 = lgt[e]; i2 = e; }
                const float w2 = 1.f / (1.f + __expf(v1 - v2)), w1 = 1.f - w2;
                unsigned p1 = 0, p2 = 0;
                if (ln_ == 0) { p1 = __hip_atomic_fetch_add(cnt + 64 * i1, 1u, RLX_AGENT); p2 = __hip_atomic_fetch_add(cnt + 64 * i2, 1u, RLX_AGENT); }
                p1 = (unsigned)__builtin_amdgcn_readfirstlane((int)p1); p2 = (unsigned)__builtin_amdgcn_readfirstlane((int)p2);
                const size_t r1 = (size_t)i1 * CAP + p1, r2 = (size_t)i2 * CAP + p2;
                if (ln_ == 0) { int* rts = (int*)(F.ws + WS_ROWTS); float* rww = (float*)(F.ws + WS_ROWW); rts[r1] = 2 * row; rww[r1] = w1; rts[r2] = 2 * row + 1; rww[r2] = w2; }
#pragma unroll
                for (int j = 0; j < 8; ++j) { v2u o; o.x = pk2(v[j][0], v[j][1]); o.y = pk2(v[j][2], v[j][3]);
                    *(GAS v2u*)(hmb + r1 * D + 256 * j + 4 * ln_) = o; *(GAS v2u*)(hmb + r2 * D + 256 * j + 4 * ln_) = o; }
            }
        }
    }
}
#undef LN_LOAD
__device__ __forceinline__ void mod_phase(Frame& F, const float* x, const float* mod, bf16* hmb) {
    const int ln_ = pg8::launder(F.lane);
    f32x4 xr[8];
#define MOD_LOAD(r_) do { _Pragma("unroll") for (int j = 0; j < 8; ++j) xr[j] = *(const GAS f32x4*)(x + (size_t)(r_) * D + 256 * j + 4 * ln_); } while (0)
    if (F.gw < T) MOD_LOAD(F.gw);
    for (int row = F.gw; row < T; row += F.NGW) { const float* mn = mod + (size_t)(row / S) * 3 * D; f32x4 v[8];
#pragma unroll
        for (int j = 0; j < 8; ++j) { const int col = 256 * j + 4 * ln_; v[j] = xr[j] * (*(const GAS f32x4*)(mn + D + col) + 1.f) + *(const GAS f32x4*)(mn + col); }
        if (row + F.NGW < T) MOD_LOAD(row + F.NGW);
#pragma unroll
        for (int j = 0; j < 8; ++j) { v2u o; o.x = pk2(v[j][0], v[j][1]); o.y = pk2(v[j][2], v[j][3]); *(GAS v2u*)(hmb + (size_t)row * D + 256 * j + 4 * ln_) = o; } }
#undef MOD_LOAD
}
__device__ __forceinline__ void pool_phase(Frame& F, const float* X, const float* mod, bf16* PD) {
    const int ln_ = pg8::launder(F.lane);
    for (int u = F.gw; u < (T / 32) * 8; u += F.NGW) {
        const int chunk = u >> 3, sl = u & 7, t0 = chunk * 32, b = t0 / S, tl0 = t0 % S, col = sl * 256 + 4 * ln_, w = 2 << (sl >> 1);
        const float* mn = mod + (size_t)b * 3 * D; const f32x4 sc = *(const GAS f32x4*)(mn + D + col) + 1.f, sh = *(const GAS f32x4*)(mn + col);
        const float* xp = X + (size_t)t0 * D + col;
        f32x4 sum = (f32x4){0.f, 0.f, 0.f, 0.f};
        for (int jj = 1; jj < w; ++jj) if (tl0 - jj >= 0) sum += *(const GAS f32x4*)(xp - (size_t)jj * D) * sc + sh;
#pragma unroll 4
        for (int i = 0; i < 32; ++i) { const int tl = tl0 + i; const f32x4 h = *(const GAS f32x4*)(xp + (size_t)i * D) * sc + sh; sum += h;
            const int cnt = (tl + 1 < w) ? tl + 1 : w; const f32x4 o = sum * (1.f / (float)cnt) - h;
            v2u ob; ob.x = pk2(o[0], o[1]); ob.y = pk2(o[2], o[3]); *(GAS v2u*)(PD + (size_t)(t0 + i) * D + col) = ob;
            if (tl - w + 1 >= 0) sum -= *(const GAS f32x4*)(xp + (long)(i - w + 1) * D) * sc + sh; }
    }
}
__device__ __forceinline__ void krope_phase(Frame& F) {
    const float* kraw = (const float*)(F.ws + WS_KRAW); const float* cs = (const float*)(F.ws + WS_COS); const float* sn = (const float*)(F.ws + WS_SIN); bf16* krb = (bf16*)(F.ws + WS_KRB);
    for (int i = F.vcu * 512 + pg8::launder(F.tid); i < T * 32; i += F.G * 512) { const int t = i >> 5, f = i & 31; const float x1 = kraw[t * 64 + f], x2 = kraw[t * 64 + 32 + f], c = cs[i], s = sn[i];
        krb[t * 64 + f] = (bf16)(pk2(x1 * c - x2 * s, 0.f) & 0xffffu); krb[t * 64 + 32 + f] = (bf16)(pk2(x1 * s + x2 * c, 0.f) & 0xffffu); }
}
constexpr int NPH_PRE = 2, NPH_PAIR = 15, NPH = NPH_PRE + 2 * NPH_PAIR;
struct Args { const float* in[27]; float* out; unsigned char* ws; int ph_lo, ph_hi; };

__global__ void __launch_bounds__(NWAVES * 64, 2) mega_fwd(Args args) {
    extern __shared__ __attribute__((aligned(16))) unsigned char lds[];
    Frame F;
    F.lds = (LAS unsigned char*)lds; F.MISC = (volatile LAS unsigned*)(F.lds + MISC_OFF);
    F.tid = threadIdx.x; F.lane = F.tid & 63; F.wave = __builtin_amdgcn_readfirstlane(F.tid >> 6);
    F.G = gridDim.x; { const int bx = blockIdx.x; F.vcu = (F.G % 8 == 0) ? (bx % 8) * (F.G / 8) + bx / 8 : bx; }
    F.gw = F.vcu * NWAVES + F.wave; F.NGW = F.G * NWAVES;
    F.ws = args.ws; F.ctl = (gu32*)(args.ws + WS_CTL); F.out = args.out;
    F.in = args.in;
    for (int u = F.tid; u < (LDS_BYTES - LDSCTL_OFF) / 4; u += NWAVES * 64) ((LAS unsigned*)(F.lds + LDSCTL_OFF))[u] = 0u;
    __syncthreads();
    const int lo = args.ph_lo, hi = args.ph_hi; const bool use_bar = (hi - lo) > 1;
    XcdBarrier bar; bar.bar = (unsigned*)(F.ctl + CW_BAR); bar.x = 0; bar.st = nullptr;
    if (use_bar) bar = xcd_barrier_post((unsigned*)(F.ctl + CW_BAR), F.MISC + 8);
#ifndef PH_EN
#define PH_EN 0xFFFFFFFFu
#endif
#define CLS(k) ((k) < NPH_PRE ? (k) : NPH_PRE + ((k) - NPH_PRE) % NPH_PAIR)
#define IN(k) (((PH_EN >> CLS(k)) & 1u) && lo <= (k) && (k) < hi)
#ifndef DUP_CLS
#define DUP_CLS -1
#endif
#ifndef DUP_N
#define DUP_N 1
#endif
#define REP(k) for (int rep_ = 0; rep_ < ((CLS(k) == DUP_CLS) ? DUP_N : 1); ++rep_)
#define SEAM(k) do { if (IN(k) && IN((k) + 1)) xcd_barrier(bar); } while (0)
    unsigned char* ws = args.ws;
    float* MOD = (float*)(ws + WS_MOD); float* X = (float*)(ws + WS_X); float* VB = (float*)(ws + WS_VB); bf16* HMb = (bf16*)(ws + WS_HMB); bf16* WbE = (bf16*)(ws + WS_WE); bf16* WbO = (bf16*)(ws + WS_WO);
    bf16* CQ = (bf16*)(ws + WS_CQ); bf16* CKV = (bf16*)(ws + WS_CKV); bf16* ZU = (bf16*)(ws + WS_ZU); bf16* ZV = (bf16*)(ws + WS_ZV); bf16* QB = (bf16*)(ws + WS_QB); bf16* KVB = (bf16*)(ws + WS_KVB);
    bf16* CAT = (bf16*)(ws + WS_CAT); bf16* H = (bf16*)(ws + WS_H); bf16* PD = (bf16*)(ws + WS_PD); bf16* PP = (bf16*)(ws + WS_PP); bf16* HMS = (bf16*)(ws + WS_HMS); bf16* HS = (bf16*)(ws + WS_HS);
    float* YS = (float*)(ws + WS_YS); float* SSQQ = (float*)(ws + WS_SSQQ); float* SSQKV = (float*)(ws + WS_SSQKV); float* KRAW = (float*)(ws + WS_KRAW); bf16* KRB = (bf16*)(ws + WS_KRB);
    const float* COS = (const float*)(ws + WS_COS); const float* SIN = (const float*)(ws + WS_SIN);
    const int bx = (int)blockIdx.x;
    LAS int* moetab = (LAS int*)(F.lds + LDSCTL_OFF);
#define MODP(l, s) (MOD + (size_t)((l) * 2 + (s)) * 2 * 3 * D)
#define MOE_TAB(cntp, ncol) do { if (F.tid == 0) { int cum = 0; for (int e = 0; e < NE; ++e) { const int n = (int)__hip_atomic_load((cntp) + 64 * e, RLX_AGENT); const int nr = (n + 255) >> 8; \
        moetab[e] = cum; moetab[9 + e] = nr; cum += nr * (ncol); } moetab[8] = cum; } __syncthreads(); } while (0)

#ifndef CV_E1
#define CV_E1 8000
#endif
#ifndef CV_E6
#define CV_E6 16000
#endif
    if (IN(0)) REP(0) { ada_phase(F); rope_tab_phase(F); convert_even(F, 0, 0, NIT_EVEN, F.gw, F.NGW); }
    SEAM(0);
    if (IN(1)) REP(1) { mod_phase(F, F.in[0], MODP(0, 0), HMb); }
    SEAM(1);
    for (int j = 0; j < 2; ++j) {
        const int pb = NPH_PRE + NPH_PAIR * j, l0 = 2 * j, l1 = 2 * j + 1;
        const float* ln_g = F.in[5]; const float* ln_b = F.in[6];
        constexpr int NU1 = (T / 256) * (INWP / 256), NU6 = (T / 256) * (2 * FF / 256);
        const bool has1 = NU1 % F.G != 0, has6 = NU6 % F.G != 0; const int hi1 = has1 ? CV_E1 : 0, hi6 = hi1 + (has6 ? CV_E6 : 0);
        if (IN(pb + 0)) REP(pb + 0) {
            pg8::StaticOrder So; So.init(T, INWP, F.G, bx, HMb, D, WbE + WE_IN, D);
            pg8::EpiIn E{CQ, CKV, ZU, ZV, KRAW, SSQQ, SSQKV};
            pg8::gemm_phase<pg8::EpiIn, pg8::StaticOrder, true>(F.lds, D, D, D, So, E);
            if (has1 && bx >= NU1 % F.G) convert_odd(F, j, 0, hi1, (bx - NU1 % F.G) * NWAVES + F.wave, (F.G - NU1 % F.G) * NWAVES);
        }
        SEAM(pb + 0);
        if (IN(pb + 1)) REP(pb + 1) {
            krope_phase(F);
            { pg8::StaticOrder So; So.init(T, QW, F.G, bx, CQ, QL, WbE + WE_Q, QL); pg8::EpiQ E{QB, SSQQ, COS, SIN}; pg8::gemm_phase<pg8::EpiQ, pg8::StaticOrder, true>(F.lds, QL, QL, QL, So, E); }
            { pg8::StaticOrder So; So.init(T, KVW, F.G, bx, CKV, KVL, WbE + WE_KV, KVL); pg8::EpiKV E{KVB, SSQKV}; pg8::gemm_phase<pg8::EpiKV, pg8::StaticOrder, true>(F.lds, KVL, KVL, KVL, So, E); }
            const float* sng = F.in[12] + j * SGW; const float* snb = F.in[13] + j * SGW; const float* sw = F.in[14] + (size_t)j * NG * CH * CH; const float* sb = F.in[15] + j * NG * CH;
            const bool fast = (F.G == 256);
            const int nun = fast ? (bx >= 192 ? 5 : 1) : (((T / CH) * NG - bx + F.G - 1) / F.G);
            for (int k = 0; k < nun; ++k) { const int u = fast ? ((bx >= 192 && k < 4) ? (bx - 192) * 4 + k : 256 + bx) : bx + k * F.G;
                sgu::sgu_unit(u >> 3, u & 7, ZU, ZV, sng, snb, sw, sb, CAT, (char*)lds); }
        }
        SEAM(pb + 1);
        if (IN(pb + 2)) REP(pb + 2) {
            for (int it = F.vcu; it < NB * NH * 16; it += F.G) { const int bh = it >> 4, x = it & 15;
                for (int pass = 0; pass < 2; ++pass) attn::attn_block(bh >> 3, bh & 7, pass ? x : 31 - x, QB, KVB, KRB, CAT, (char*)lds); }
        }
        SEAM(pb + 2);
        if (IN(pb + 3)) REP(pb + 3) {
            pg8::StaticOrder So; So.init(T, D, F.G, bx, CAT, 2048, WbE + WE_OUT, 2048);
            pg8::EpiY E{MODP(l0, 0), (bf16*)VB};
            pg8::gemm_phase<pg8::EpiY, pg8::StaticOrder, true>(F.lds, 2048, 2048, 2048, So, E);
        }
        SEAM(pb + 3);
        if (IN(pb + 4)) REP(pb + 4) ln_phase<0, 1>(F, VB, (j == 0) ? F.in[0] : X, nullptr, nullptr, ln_g + (size_t)(l0 * 2) * D, ln_b + (size_t)(l0 * 2) * D, X, MODP(l0, 1), HMb, nullptr, nullptr, true);
        SEAM(pb + 4);
        if (IN(pb + 5)) REP(pb + 5) {
            pg8::StaticOrder So; So.init(T, 2 * FF, F.G, bx, HMb, D, WbE + WE_GU, D);
            pg8::EpiSwiGLU E{H, FF};
            pg8::gemm_phase<pg8::EpiSwiGLU, pg8::StaticOrder, true>(F.lds, D, D, D, So, E);
            if (has6 && bx >= NU6 % F.G) convert_odd(F, j, hi1, hi6, (bx - NU6 % F.G) * NWAVES + F.wave, (F.G - NU6 % F.G) * NWAVES);
        }
        SEAM(pb + 5);
        if (IN(pb + 6)) REP(pb + 6) {
            pg8::StaticOrder So; So.init(T, D, F.G, bx, H, FF, WbE + WE_DN, FF);
            pg8::EpiY E{MODP(l0, 1), (bf16*)VB};
            pg8::gemm_phase<pg8::EpiY, pg8::StaticOrder, true>(F.lds, FF, FF, FF, So, E);
        }
        SEAM(pb + 6);
        if (IN(pb + 7)) REP(pb + 7) { ln_phase<0, 0>(F, VB, X, nullptr, nullptr, ln_g + (size_t)(l0 * 2 + 1) * D, ln_b + (size_t)(l0 * 2 + 1) * D, X, nullptr, nullptr, nullptr, nullptr, false); convert_odd(F, j, hi6, NIT_ODD, F.gw, F.NGW); }
        SEAM(pb + 7);
        if (IN(pb + 8)) REP(pb + 8) pool_phase(F, X, MODP(l1, 0), PD);
        SEAM(pb + 8);
        if (IN(pb + 9)) REP(pb + 9) {
            pg8::StaticOrder So; So.init(T, D, F.G, bx, PD, D, WbO + WO_POOL, 512, 1, 512);
            pg8::EpiScaleBf16 E{PP, D, F.in[21] + j * D};
            pg8::gemm_phase<pg8::EpiScaleBf16, pg8::StaticOrder, true>(F.lds, 512, D, 512, So, E);
        }
        SEAM(pb + 9);
        if (IN(pb + 10)) REP(pb + 10) {
            pg8::StaticOrder So; So.init(T, D, F.G, bx, PP, D, WbO + WO_OC, D);
            pg8::EpiY E{MODP(l1, 0), (bf16*)VB};
            pg8::gemm_phase<pg8::EpiY, pg8::StaticOrder, true>(F.lds, D, D, D, So, E);
        }
        SEAM(pb + 10);
        gu32* mcnt = F.ctl + CW_MOECNT + j * NE * 64;
        if (IN(pb + 11)) REP(pb + 11) ln_phase<0, 2>(F, VB, X, nullptr, nullptr, ln_g + (size_t)(l1 * 2) * D, ln_b + (size_t)(l1 * 2) * D, X, MODP(l1, 1), HMS, F.in[23] + (size_t)j * D * NE, mcnt, true);
        SEAM(pb + 11);
        if (IN(pb + 12)) REP(pb + 12) {
            MOE_TAB(mcnt, 2 * FE / 256);
            pg8::MoeOrder So{(const PG8_LAS int*)moetab, 2 * FE / 256, F.G, bx, (const char*)HMS, (const char*)(WbO + WO_GU), D, D, (size_t)2 * FE * D * 2};
            pg8::EpiSwiGLU E{HS, FE};
            pg8::gemm_phase<pg8::EpiSwiGLU, pg8::MoeOrder, true>(F.lds, D, D, D, So, E);
            __syncthreads();
        }
        SEAM(pb + 12);
        if (IN(pb + 13)) REP(pb + 13) {
            MOE_TAB(mcnt, D / 256);
            pg8::MoeOrder So{(const PG8_LAS int*)moetab, D / 256, F.G, bx, (const char*)HS, (const char*)(WbO + WO_DN), FE, FE, (size_t)D * FE * 2};
            pg8::EpiMoeDown E{(bf16*)YS, (const int*)(ws + WS_ROWTS), (const float*)(ws + WS_ROWW), (const unsigned*)mcnt};
            pg8::gemm_phase<pg8::EpiMoeDown, pg8::MoeOrder, true>(F.lds, FE, FE, FE, So, E);
            __syncthreads();
            if (j == 0) { const int nwg = __builtin_amdgcn_readfirstlane(moetab[8]), r3 = nwg - 2 * F.G;
                if (r3 > 0 && r3 < F.G && bx >= r3) convert_even(F, 1, 0, NIT_EVEN, (bx - r3) * NWAVES + F.wave, (F.G - r3) * NWAVES); }
        }
        SEAM(pb + 13);
        if (IN(pb + 14)) REP(pb + 14) {
            ln_phase<1, 1>(F, nullptr, X, MODP(l1, 1), YS, ln_g + (size_t)(l1 * 2 + 1) * D, ln_b + (size_t)(l1 * 2 + 1) * D, (j == 1) ? F.out : X, MODP((j == 0) ? l1 + 1 : 0, 0), HMb, nullptr, nullptr, j == 0);
            if (j == 0) { int nwg = 0; for (int e = 0; e < NE; ++e) nwg += (((int)__hip_atomic_load(mcnt + 64 * e, RLX_AGENT) + 255) >> 8) * (D / 256);
                const int r3 = nwg - 2 * F.G; if (!(r3 > 0 && r3 < F.G)) convert_even(F, 1, 0, NIT_EVEN, F.gw, F.NGW); }
        }
        SEAM(pb + 14);
    }
#undef IN
#undef SEAM
#undef MODP
#undef MOE_TAB
}
#ifndef MEGA_PHASES
#define MEGA_PHASES 32
#endif
#ifndef MEGA_ONE_LAUNCH
#define MEGA_ONE_LAUNCH 1
#endif
constexpr int scaffold_start(int ph) {
    if (ph == 0) return 0;
    for (int j = 0; j < 2; ++j) { const int pb = NPH_PRE + NPH_PAIR * j; if (ph == pb + 5) return 4 * j + 1; if (ph == pb + 8) return 4 * j + 2; if (ph == pb + 12) return 4 * j + 3; if (ph == pb + 15) return 4 * j + 4; }
    return -1;
}
static_assert(scaffold_start(MEGA_PHASES) >= 0, "MEGA_PHASES must end at a sub-layer boundary");

#if MEGA_PHASES < 32
template <int MODE>
static void sgemm(hipStream_t st, const float* A, int lda, const float* W, int ldw, float* C, int ldc, int M, int N, int K, const int* rowidx = nullptr, const int* tile_e = nullptr, size_t wstride = 0) {
    hipLaunchKernelGGL(scaf::k_gemm<MODE>, dim3(N / 64, M / 128), dim3(256), 0, st, A, lda, W, ldw, C, ldc, K, rowidx, tile_e, wstride);
}
static void scaffold_run(void* const* d_in, float* d_out, unsigned char* wsb, int K0, hipStream_t stream) {
    using namespace scaf;
    const float* x_in = (const float*)d_in[0]; const float* c = (const float*)d_in[1]; const int* positions = (const int*)d_in[2];
    const float* ada_w = (const float*)d_in[3]; const float* ada_b = (const float*)d_in[4]; const float* ln_g = (const float*)d_in[5]; const float* ln_b = (const float*)d_in[6];
    const float* w_in_ab = (const float*)d_in[7]; const float* q_norm_g = (const float*)d_in[8]; const float* w_q_up = (const float*)d_in[9]; const float* kv_norm_g = (const float*)d_in[10];
    const float* w_kv_up = (const float*)d_in[11]; const float* sgu_norm_g = (const float*)d_in[12]; const float* sgu_norm_b = (const float*)d_in[13]; const float* sgu_w = (const float*)d_in[14];
    const float* sgu_b = (const float*)d_in[15]; const float* w_out_ab = (const float*)d_in[16]; const float* ffn_w_gate = (const float*)d_in[17]; const float* ffn_w_up = (const float*)d_in[18];
    const float* ffn_w_down = (const float*)d_in[19]; const float* pool_w = (const float*)d_in[20]; const float* pool_scale = (const float*)d_in[21]; const float* w_out_c = (const float*)d_in[22];
    const float* router_w = (const float*)d_in[23]; const float* moe_w_gate = (const float*)d_in[24]; const float* moe_w_up = (const float*)d_in[25]; const float* moe_w_down = (const float*)d_in[26];
    float* X = (float*)(wsb + WS_X);
    float* ws = (float*)(wsb + WS_END); size_t off = 0;
    auto take = [&](size_t n) { float* p = ws + off; off += (n + 63) / 64 * 64; return p; };
    float* MOD = take((size_t)8 * 2 * 3 * D); float* COS = take((size_t)T * 32); float* SIN = take((size_t)T * 32);
    float* HM = take((size_t)T * D); float* Y = take((size_t)T * D);
    int* TOPI = (int*)take((size_t)T * 2); float* TOPW = take((size_t)T * 2); int* ROWIDX = (int*)take(MPAD); int* TILEE = (int*)take(MTILES); int* POS = (int*)take((size_t)T * 2);
    float* ARENA = (float*)(wsb + WS_ACT);
    size_t ao = 0; auto atake = [&](size_t n) { float* p = ARENA + ao; ao += (n + 63) / 64 * 64; return p; };
    float* Z = atake((size_t)T * INW); float* CQN = atake((size_t)T * QL); float* CKVN = atake((size_t)T * KVL); float* Q = atake((size_t)T * QW); float* KV = atake((size_t)T * KVW);
    float* KR = atake((size_t)T * 64); float* U = atake((size_t)T * SGW); float* VG = atake((size_t)T * SGW); float* CAT = atake((size_t)T * 2048);
    float* HG = ARENA; float* HU = ARENA + (size_t)MPAD * FE; float* YS = ARENA + (size_t)2 * MPAD * FE;
    float* PD = ARENA; float* PP = ARENA + (size_t)T * D;
    static_assert((size_t)MPAD * FE >= (size_t)T * FF && ((size_t)2 * MPAD * FE + (size_t)MPAD * D) * 4 <= WS_END - WS_ACT, "arena");
    const int EB = 256; const unsigned gTD = (unsigned)(((size_t)T * D + EB - 1) / EB);
    if (K0 == 0) (void)hipMemcpyAsync(X, x_in, (size_t)T * D * 4, hipMemcpyDeviceToDevice, stream);
    hipLaunchKernelGGL(k_ada, dim3(3 * D / 256, 8), dim3(256), 0, stream, c, ada_w, ada_b, MOD);
    hipLaunchKernelGGL(k_rope_tab, dim3(T * 32 / 256), dim3(256), 0, stream, positions, COS, SIN);
    for (int step = K0; step < 8; ++step) {
        const int l = step >> 1, sl = step & 1, j = l / 2; const float* mod = MOD + (size_t)step * 2 * 3 * D;
        hipLaunchKernelGGL(k_modulate, dim3(gTD), dim3(EB), 0, stream, X, mod, HM);
        if (sl == 0) {
            if ((l & 1) == 0) {
                sgemm<0>(stream, HM, D, w_in_ab + (size_t)j * D * INW, INW, Z, INW, T, INW, D);
                hipLaunchKernelGGL(k_rms, dim3(T), dim3(256), 0, stream, Z, INW, 0, QL, q_norm_g + j * QL, CQN);
                hipLaunchKernelGGL(k_rms, dim3(T), dim3(256), 0, stream, Z, INW, QL, KVL, kv_norm_g + j * KVL, CKVN);
                sgemm<0>(stream, CQN, QL, w_q_up + (size_t)j * QL * QW, QW, Q, QW, T, QW, QL);
                hipLaunchKernelGGL(k_rope_q, dim3(T * NH * 32 / 256), dim3(256), 0, stream, Q, COS, SIN);
                sgemm<0>(stream, CKVN, KVL, w_kv_up + (size_t)j * KVL * KVW, KVW, KV, KVW, T, KVW, KVL);
                hipLaunchKernelGGL(k_rope_k, dim3(T * 32 / 256), dim3(256), 0, stream, Z, KR, COS, SIN);
                hipLaunchKernelGGL(k_attn, dim3(NB * NH * S), dim3(256), 0, stream, Q, KV, KR, CAT);
                hipLaunchKernelGGL(k_sgu_pre, dim3(T * NG * 64 / 256), dim3(256), 0, stream, Z, sgu_norm_g + j * SGW, sgu_norm_b + j * SGW, U, VG);
                hipLaunchKernelGGL(k_sgu_mix, dim3(T * NG), dim3(128), 0, stream, U, VG, sgu_w + (size_t)j * NG * CH * CH, sgu_b + j * NG * CH, CAT);
                sgemm<0>(stream, CAT, 2048, w_out_ab + (size_t)j * 2048 * D, D, Y, D, T, D, 2048);
            } else {
                hipLaunchKernelGGL(k_pool, dim3(gTD), dim3(EB), 0, stream, HM, PD);
                for (int gi = 0; gi < 4; ++gi) sgemm<0>(stream, PD + gi * 512, D, pool_w + ((size_t)j * 4 + gi) * 512 * 512, 512, PP + gi * 512, D, T, 512, 512);
                hipLaunchKernelGGL(k_colscale, dim3(gTD), dim3(EB), 0, stream, PP, pool_scale + j * D);
                sgemm<0>(stream, PP, D, w_out_c + (size_t)j * D * D, D, Y, D, T, D, D);
            }
        } else {
            if ((l & 1) == 0) {
                sgemm<0>(stream, HM, D, ffn_w_gate + (size_t)j * D * FF, FF, HG, FF, T, FF, D);
                sgemm<0>(stream, HM, D, ffn_w_up + (size_t)j * D * FF, FF, HU, FF, T, FF, D);
                hipLaunchKernelGGL(k_swiglu, dim3((unsigned)(((size_t)T * FF + EB - 1) / EB)), dim3(EB), 0, stream, HG, HU, (size_t)T * FF);
                sgemm<0>(stream, HG, FF, ffn_w_down + (size_t)j * FF * D, D, Y, D, T, D, FF);
            } else {
                hipLaunchKernelGGL(k_router, dim3(T * 64 / 256), dim3(256), 0, stream, HM, router_w + (size_t)j * D * NE, TOPI, TOPW);
                hipLaunchKernelGGL(k_sort, dim3(1), dim3(64), 0, stream, TOPI, ROWIDX, TILEE, POS);
                sgemm<1>(stream, HM, D, moe_w_gate + (size_t)j * NE * D * FE, FE, HG, FE, MPAD, FE, D, ROWIDX, TILEE, (size_t)D * FE);
                sgemm<1>(stream, HM, D, moe_w_up + (size_t)j * NE * D * FE, FE, HU, FE, MPAD, FE, D, ROWIDX, TILEE, (size_t)D * FE);
                hipLaunchKernelGGL(k_swiglu, dim3((unsigned)(((size_t)MPAD * FE + EB - 1) / EB)), dim3(EB), 0, stream, HG, HU, (size_t)MPAD * FE);
                sgemm<2>(stream, HG, FE, moe_w_down + (size_t)j * NE * FE * D, D, YS, D, MPAD, D, FE, nullptr, TILEE, (size_t)FE * D);
                hipLaunchKernelGGL(k_moe_combine, dim3(gTD), dim3(EB), 0, stream, YS, POS, TOPW, Y);
            }
        }
        float* xo = (step == 7) ? d_out : X;
        hipLaunchKernelGGL(k_deepnorm, dim3(T), dim3(256), 0, stream, X, Y, mod, ln_g + (size_t)step * D, ln_b + (size_t)step * D, xo);
    }
}

#endif

extern "C" void kernel_launch(void* const* d_in, const int* in_sizes, int n_in, void* d_out, int out_size, void* d_ws, size_t ws_size, hipStream_t stream) {
    (void)in_sizes;
    static int grid = 0;
    if (grid == 0) {
        constexpr size_t need = (MEGA_PHASES == NPH) ? WS_END : WS_END + 160 * MiB;
        if (n_in != 27 || out_size != T * D || ws_size < need) { fprintf(stderr, "kernel_launch: built for 27 inputs, %d outputs, >= %zu bytes of workspace; got n_in %d out %d ws %zu; nothing launched\n", T * D, need, n_in, out_size, ws_size); grid = -1; return; }
        int dev = 0, cus = 0, per_cu = 0;
        if (hipGetDevice(&dev) != hipSuccess || hipDeviceGetAttribute(&cus, hipDeviceAttributeMultiprocessorCount, dev) != hipSuccess) { fprintf(stderr, "kernel_launch: device query failed\n"); grid = -1; return; }
        if (hipFuncSetAttribute((const void*)mega_fwd, hipFuncAttributeMaxDynamicSharedMemorySize, LDS_BYTES) != hipSuccess) { fprintf(stderr, "kernel_launch: hipFuncSetAttribute failed\n"); grid = -1; return; }
        if (hipOccupancyMaxActiveBlocksPerMultiprocessor(&per_cu, (const void*)mega_fwd, NWAVES * 64, LDS_BYTES) != hipSuccess || per_cu < 1)
            fprintf(stderr, "kernel_launch: note: occupancy query reports %d workgroups per CU\n", per_cu);
        (void)hipGetLastError();
        grid = cus;
    }
    if (grid < 0) return;
    if (MEGA_PHASES > 0) {
        if (hipMemsetAsync((char*)d_ws + WS_CTL, 0, CTL_ZERO_BYTES, stream) != hipSuccess) { fprintf(stderr, "kernel_launch: memset failed\n"); return; }
        Args a{};
        for (int i = 0; i < 27; ++i) a.in[i] = (const float*)d_in[i];
        a.out = (float*)d_out; a.ws = (unsigned char*)d_ws;
        if (MEGA_ONE_LAUNCH) { a.ph_lo = 0; a.ph_hi = MEGA_PHASES; hipLaunchKernelGGL(mega_fwd, dim3(grid), dim3(NWAVES * 64), LDS_BYTES, stream, a); }
        else for (int p = 0; p < MEGA_PHASES; ++p) { a.ph_lo = p; a.ph_hi = p + 1; hipLaunchKernelGGL(mega_fwd, dim3(grid), dim3(NWAVES * 64), LDS_BYTES, stream, a); }
        const hipError_t le = hipPeekAtLastError();
        if (le != hipSuccess) fprintf(stderr, "kernel_launch: launch failed: %s\n", hipGetErrorName(le));
    }
#if MEGA_PHASES < 32
    scaffold_run(d_in, (float*)d_out, (unsigned char*)d_ws, scaffold_start(MEGA_PHASES), stream);
#endif
}
```
